# Optimizing an MI355X kernel written in HIP

```python
import math
import jax, jax.numpy as jnp
from jax import lax
import numpy as np

D_MODEL = 2048
BATCH = 4
SEQ = 2048
DEPTH = 4
DEC_BATCH = 8
DEC_SEQ = 8
PAST_LEN = 16384
PAGE_SIZE = 128

MIX_W = D_MODEL
ATT_W = MIX_W // 2
HEAD_DIM = 64
N_HEADS = ATT_W // HEAD_DIM
CONV_CH = MIX_W - ATT_W
CONV_K = 31
DILATED_BRANCHES = ((128, 1), (512, 4), (2048, 16))
MAX_WINDOW = max(w for w, _ in DILATED_BRANCHES)
D_FF = ((8 * D_MODEL + 3 * 256 - 1) // (3 * 256)) * 256
N_MOD = 6
EPS = 1e-6
ATTN_SCALE = HEAD_DIM ** -0.5
NEG = -1e30

kernel_name = 'hymba_dilated_conformer_decoder_step'


def alibi_slopes(n):
    def pow2(m):
        start = 2.0 ** (-8.0 / m)
        return [start ** (i + 1) for i in range(m)]
    if math.log2(n).is_integer():
        s = pow2(n)
    else:
        m = 2 ** math.floor(math.log2(n))
        s = pow2(m) + pow2(2 * m)[0::2][: n - m]
    return jnp.asarray(np.array(s, dtype=np.float32))


def rms_norm(x, g):
    x32 = x.astype(jnp.float32)
    y = x32 * lax.rsqrt(jnp.mean(x32 * x32, axis=-1, keepdims=True) + EPS)
    return (y * g.astype(jnp.float32)).astype(x.dtype)


def layer_norm(x, g, b):
    x32 = x.astype(jnp.float32)
    mu = jnp.mean(x32, axis=-1, keepdims=True)
    xc = x32 - mu
    y = xc * lax.rsqrt(jnp.mean(xc * xc, axis=-1, keepdims=True) + EPS)
    return (y * g.astype(jnp.float32) + b.astype(jnp.float32)).astype(x.dtype)


def dilated_branch_prompt(q, k, v, window, dilation, slopes):
    B, S, H, Dh = q.shape
    steps = window // dilation
    L = steps
    span = dilation * L
    Sp = -(-S // span) * span
    A = Sp // dilation
    nb = A // L

    def strided(x):
        x = jnp.pad(x, ((0, 0), (0, Sp - S), (0, 0), (0, 0)))
        x = x.reshape(B, A, dilation, H, Dh).transpose(0, 2, 1, 3, 4)
        return x.reshape(B * dilation, nb, L, H, Dh)

    def with_prev(x):
        prev = jnp.pad(x[:, :-1], ((0, 0), (1, 0), (0, 0), (0, 0), (0, 0)))
        return jnp.concatenate([prev, x], axis=2)

    qs = strided(q)
    kc = with_prev(strided(k))
    vc = with_prev(strided(v))
    s = jnp.einsum('bnqhd,bnkhd->bnhqk', qs, kc) * ATTN_SCALE
    qi = jnp.arange(L)[:, None]
    ki = jnp.arange(2 * L)[None, :]
    j = L + qi - ki
    blk = jnp.arange(nb)[:, None, None]
    valid = (j >= 0)[None] & (j <= steps)[None] & ((blk * L - L + ki[None]) >= 0)
    bias = -slopes[:, None, None] * (j * dilation).astype(jnp.float32)[None]
    s = jnp.where(valid[None, :, None, :, :], s + bias[None, None], NEG)
    lse = jax.nn.logsumexp(s, axis=-1)
    p = jnp.exp(s - lse[..., None])
    o = jnp.einsum('bnhqk,bnkhd->bnqhd', p, vc)

    def unstride(x):
        rest = x.shape[3:]
        x = x.reshape((B, dilation, A) + rest)
        x = jnp.moveaxis(x, 1, 2)
        return x.reshape((B, Sp) + rest)[:, :S]

    o = unstride(o)
    lse = unstride(lse.transpose(0, 1, 3, 2)[..., None])[..., 0]
    return o, lse


def dilated_branch_decode(q, k_ext, v_ext, n_past, window, dilation, slopes):
    T = q.shape[1]
    steps = window // dilation
    jj = jnp.arange(steps + 1)
    idx = n_past + jnp.arange(T)[:, None] - jj[None, :] * dilation
    valid = idx >= 0
    idx_c = jnp.maximum(idx, 0)
    kg = k_ext[:, idx_c]
    vg = v_ext[:, idx_c]
    s = jnp.einsum('bthd,btjhd->bhtj', q, kg) * ATTN_SCALE
    bias = -slopes[:, None, None] * (jj * dilation).astype(jnp.float32)[None, None, :]
    s = jnp.where(valid[None, None], s + bias[None], NEG)
    lse = jax.nn.logsumexp(s, axis=-1)
    p = jnp.exp(s - lse[..., None])
    o = jnp.einsum('bhtj,btjhd->bthd', p, vg)
    return o, lse.transpose(0, 2, 1)


def merge_branches(outs, lses):
    w = jax.nn.softmax(jnp.stack(lses), axis=0)
    return jnp.sum(w[..., None] * jnp.stack(outs), axis=0)


def attention_prompt(q, k, v, slopes):
    S = q.shape[1]
    q32, k32, v32 = q.astype(jnp.float32), k.astype(jnp.float32), v.astype(jnp.float32)
    outs, lses = [], []
    for window, dilation in DILATED_BRANCHES:
        o_i, l_i = dilated_branch_prompt(q32, k32, v32, window, dilation, slopes)
        outs.append(o_i)
        lses.append(l_i)
    keep = min(MAX_WINDOW, S)
    return merge_branches(outs, lses), k[:, S - keep:], v[:, S - keep:]


def attention_decode(q, k, v, past_k, past_v, slopes):
    n_past = past_k.shape[1]
    k_ext = jnp.concatenate([past_k, k.astype(past_k.dtype)], axis=1)
    v_ext = jnp.concatenate([past_v, v.astype(past_v.dtype)], axis=1)
    q32, k32, v32 = q.astype(jnp.float32), k_ext.astype(jnp.float32), v_ext.astype(jnp.float32)
    outs, lses = [], []
    for window, dilation in DILATED_BRANCHES:
        o_i, l_i = dilated_branch_decode(q32, k32, v32, n_past, window, dilation, slopes)
        outs.append(o_i)
        lses.append(l_i)
    return merge_branches(outs, lses), k_ext[:, -n_past:], v_ext[:, -n_past:]


def conformer_conv(a, g, past, conv_w, conv_b, ln_g, ln_b):
    u = a * jax.nn.sigmoid(g)
    if past is None:
        past = jnp.zeros((u.shape[0], CONV_K - 1, CONV_CH), u.dtype)
    ext = jnp.concatenate([past.astype(u.dtype), u], axis=1)
    y = lax.conv_general_dilated(ext, conv_w[:, None, :].astype(u.dtype), (1,), 'VALID',
                                 dimension_numbers=('NWC', 'WIO', 'NWC'),
                                 feature_group_count=CONV_CH) + conv_b
    y = jax.nn.silu(layer_norm(y, ln_g, ln_b))
    return y, ext[:, -(CONV_K - 1):]


def layer(x, c, past_k, past_v, past_conv, slopes, g_pre_mix, g_post_mix, g_pre_ffn, g_post_ffn,
          w_mod, b_mod, w_in, g_attn_out, conv_w, conv_b, conv_ln_g, conv_ln_b, w_out, w_gu, w_down):
    B, T, _ = x.shape
    mod = jax.nn.silu(c) @ w_mod + b_mod
    sh_a, sc_a, gt_a, sh_f, sc_f, gt_f = [m[:, None, :] for m in jnp.split(mod, N_MOD, axis=-1)]

    h = rms_norm(x, g_pre_mix) * (1 + sc_a) + sh_a
    proj = h @ w_in
    q, k, v, a, g = jnp.split(proj, [ATT_W, 2 * ATT_W, 3 * ATT_W, 3 * ATT_W + CONV_CH], axis=-1)
    q = q.reshape(B, T, N_HEADS, HEAD_DIM)
    k = k.reshape(B, T, N_HEADS, HEAD_DIM)
    v = v.reshape(B, T, N_HEADS, HEAD_DIM)
    if past_k is None:
        o, new_k, new_v = attention_prompt(q, k, v, slopes)
    else:
        o, new_k, new_v = attention_decode(q, k, v, past_k, past_v, slopes)
    o = rms_norm(o.reshape(B, T, ATT_W).astype(x.dtype), g_attn_out)
    y, new_conv = conformer_conv(a, g, past_conv, conv_w, conv_b, conv_ln_g, conv_ln_b)
    mix = jnp.concatenate([o, y.astype(o.dtype)], axis=-1) @ w_out
    x = x + gt_a * rms_norm(mix, g_post_mix)

    h2 = rms_norm(x, g_pre_ffn) * (1 + sc_f) + sh_f
    gate, up = jnp.split(h2 @ w_gu, 2, axis=-1)
    f = (jax.nn.silu(gate) * up) @ w_down
    x = x + gt_f * rms_norm(f, g_post_ffn)
    return x, new_k, new_v, new_conv


def setup_inputs(seed: int = 0) -> dict:
    key = jax.random.key(seed)
    ks = jax.random.split(key, 24)
    wbuf = min(MAX_WINDOW, PAST_LEN)

    def nrm(k, shape, s):
        return s * jax.random.normal(k, shape, jnp.float32)

    return {
        'x_prompt': nrm(ks[0], (BATCH, SEQ, D_MODEL), 1.0),
        'x_sample': nrm(ks[1], (DEC_BATCH, DEC_SEQ, D_MODEL), 1.0),
        'c_prompt': nrm(ks[2], (BATCH, D_MODEL), 1.0),
        'c_sample': nrm(ks[3], (DEC_BATCH, D_MODEL), 1.0),
        'cache_win_k': nrm(ks[4], (DEPTH, DEC_BATCH, wbuf, N_HEADS, HEAD_DIM), 1.0),
        'cache_win_v': nrm(ks[5], (DEPTH, DEC_BATCH, wbuf, N_HEADS, HEAD_DIM), 1.0),
        'state_conv': nrm(ks[6], (DEPTH, DEC_BATCH, CONV_K - 1, CONV_CH), 0.5),
        'g_pre_mix': 1.0 + nrm(ks[7], (DEPTH, D_MODEL), 0.02),
        'g_post_mix': 1.0 + nrm(ks[8], (DEPTH, D_MODEL), 0.02),
        'g_pre_ffn': 1.0 + nrm(ks[9], (DEPTH, D_MODEL), 0.02),
        'g_post_ffn': 1.0 + nrm(ks[10], (DEPTH, D_MODEL), 0.02),
        'w_mod': nrm(ks[11], (DEPTH, D_MODEL, N_MOD * D_MODEL), D_MODEL ** -0.5),
        'b_mod': nrm(ks[12], (DEPTH, N_MOD * D_MODEL), 0.01),
        'w_in': nrm(ks[13], (DEPTH, D_MODEL, 3 * ATT_W + 2 * CONV_CH), D_MODEL ** -0.5),
        'g_attn_out': 1.0 + nrm(ks[14], (DEPTH, ATT_W), 0.02),
        'conv_w': nrm(ks[15], (DEPTH, CONV_K, CONV_CH), CONV_K ** -0.5),
        'conv_b': nrm(ks[16], (DEPTH, CONV_CH), 0.01),
        'conv_ln_g': 1.0 + nrm(ks[17], (DEPTH, CONV_CH), 0.02),
        'conv_ln_b': nrm(ks[18], (DEPTH, CONV_CH), 0.01),
        'w_out': nrm(ks[19], (DEPTH, MIX_W, D_MODEL), MIX_W ** -0.5),
        'w_gu': nrm(ks[20], (DEPTH, D_MODEL, 2 * D_FF), D_MODEL ** -0.5),
        'w_down': nrm(ks[21], (DEPTH, D_FF, D_MODEL), D_FF ** -0.5),
    }


def reference(x_prompt, x_sample, c_prompt, c_sample, cache_win_k, cache_win_v, state_conv,
              g_pre_mix, g_post_mix, g_pre_ffn, g_post_ffn, w_mod, b_mod, w_in, g_attn_out,
              conv_w, conv_b, conv_ln_g, conv_ln_b, w_out, w_gu, w_down):
    slopes = alibi_slopes(N_HEADS)
    yp, ys = x_prompt, x_sample
    kp_l, vp_l, cp_l, ks_l, vs_l, cs_l = [], [], [], [], [], []
    for l in range(DEPTH):
        lw = (g_pre_mix[l], g_post_mix[l], g_pre_ffn[l], g_post_ffn[l], w_mod[l], b_mod[l],
              w_in[l], g_attn_out[l], conv_w[l], conv_b[l], conv_ln_g[l], conv_ln_b[l],
              w_out[l], w_gu[l], w_down[l])
        yp, kp, vp, cp = layer(yp, c_prompt, None, None, None, slopes, *lw)
        ys, kn, vn, cn = layer(ys, c_sample, cache_win_k[l], cache_win_v[l], state_conv[l], slopes, *lw)
        kp_l.append(kp)
        vp_l.append(vp)
        cp_l.append(cp)
        ks_l.append(kn)
        vs_l.append(vn)
        cs_l.append(cn)
    return (yp, ys, jnp.stack(kp_l), jnp.stack(vp_l), jnp.stack(cp_l),
            jnp.stack(ks_l), jnp.stack(vs_l), jnp.stack(cs_l))
```

```cpp
#define PROBE_DUP -1
#include <hip/hip_runtime.h>
#include <cstdio>
#include <cstdint>
#include <cmath>
namespace pg8 {
#define PG8_LAS __attribute__((address_space(3)))
typedef unsigned short bf16_t;
typedef short bf16x8 __attribute__((ext_vector_type(8)));
typedef float f32x4 __attribute__((ext_vector_type(4)));
typedef unsigned u32x4 __attribute__((ext_vector_type(4)));
constexpr int BM = 256, BK = 64, HALF = 128, HTB = HALF * BK * 2  , STAGE_BYTES = 8 * HTB, NXCD = 8, WGM = 8;

__host__ __device__ __forceinline__ int lds_byte(int r, int c) { const int st = (r >> 4) * 2 + (c >> 5), rr = r & 15, cc = c & 31, ob = rr * 64 + cc * 2; return st * 1024 + (ob ^ (((ob >> 9) & 1) << 5)); }
__host__ __device__ __forceinline__ void stage_rc(int b, int& R, int& C) { const int st = b / 1024, sb = b % 1024, swz = sb ^ (((sb >> 9) & 1) << 5); R = (st >> 1) * 16 + swz / 64; C = (st & 1) * 32 + (swz % 64) / 2; }
__host__ __device__ __forceinline__ int perm32(int rho) { const int n = rho >> 4, i = rho & 15; return 8 * (i >> 2) + 4 * n + (i & 3); }

struct Unit { int pm, pn; };
struct Gemm { const bf16_t* A; const bf16_t* Bt; int M, N, K; };

struct StaticOrder {
    int nM, nN, nwg, G, c;
    __host__ __device__ void init(int M, int N, int G_, int c_) { nM = M / BM; nN = N / BM; nwg = nM * nN; G = G_; c = c_; }
    __host__ __device__ bool next(int i, Unit& u) const {
        const long L = (long)i * G + c; if (L >= nwg) return false;
        int wgid = (int)L; { const int q = nwg / NXCD, r = nwg % NXCD, xcd = wgid % NXCD, off = wgid / NXCD; wgid = (xcd < r ? xcd * (q + 1) : r * (q + 1) + (xcd - r) * q) + off; }
        const int nig = WGM * nN, gid = wgid / nig, fm = gid * WGM, gsz = (nM - fm) < WGM ? (nM - fm) : WGM;
        u.pm = fm + ((wgid % nig) % gsz); u.pn = (wgid % nig) / gsz; return true;
    }
    __device__ __forceinline__ void a_ready(const Unit&) const {}
    __device__ __forceinline__ void done(const Unit&) const {}
};

__device__ __forceinline__ unsigned cvt_pk_bf16(float lo, float hi) { unsigned r; asm volatile("v_cvt_pk_bf16_f32 %0, %1, %2" : "=v"(r) : "v"(lo), "v"(hi)); return r; }
constexpr int ROWS_P = 8192, ROWS_T = 8256;
__device__ __forceinline__ float sigmoidf_fast(float x) { return __builtin_amdgcn_rcpf(1.0f + __builtin_amdgcn_exp2f(-1.4426950408889634f * x)); }
__device__ __forceinline__ u32x4 pack8(const f32x4 v0, const f32x4 v1) { u32x4 w; w.x = cvt_pk_bf16(v0[0], v0[1]); w.y = cvt_pk_bf16(v0[2], v0[3]); w.z = cvt_pk_bf16(v1[0], v1[1]); w.w = cvt_pk_bf16(v1[2], v1[3]); return w; }

struct EpiIn {
    static constexpr bool PERM = true, AFTER_DRAIN = false;
    bf16_t *QKV; size_t qkv_stride;
    bf16_t *Ub; float *kvp; size_t kvp_stride;
    float *kvs; size_t kvs_stride; float qscale;
    __device__ __forceinline__ void operator()(const f32x4 (&acc)[2][2][4][2], const Unit& u, int wr, int wc, int fr, int fq) const {
        const int rbase = u.pm * BM + wr * 64 + fr;
        if (u.pn < 12) {
            const int t = u.pn >> 2, colt = (u.pn & 3) * 256 + wc * 32 + 8 * fq;
            bf16_t* dst = QKV + (size_t)t * qkv_stride; const float sc = t == 0 ? qscale : 1.f;
            float* fo_p = kvp + (size_t)(t == 2 ? 1 : 0) * kvp_stride; float* fo_s = kvs + (size_t)(t == 2 ? 1 : 0) * kvs_stride;
#pragma unroll
            for (int ai = 0; ai < 2; ++ai)
#pragma unroll
                for (int m = 0; m < 4; ++m) { const int row = rbase + ai * HALF + m * 16;
                    if (row < ROWS_T) {
                        float* fo = row < ROWS_P ? fo_p + (size_t)row * 1024 : fo_s + ((size_t)((row - ROWS_P) >> 3) * 2048 + 2040 + ((row - ROWS_P) & 7)) * 1024;
#pragma unroll
                        for (int bj = 0; bj < 2; ++bj) { const f32x4 v0 = acc[ai][bj][m][0] * sc, v1 = acc[ai][bj][m][1] * sc; const int col = colt + bj * HALF;
                            *(u32x4*)(dst + (size_t)row * 1024 + col) = pack8(v0, v1);
                            if (t != 0) { *(f32x4*)(fo + col) = v0; *(f32x4*)(fo + col + 4) = v1; } } } }
        } else {
            const int ch = (u.pn - 12) * 128 + wc * 32 + 8 * fq;
#pragma unroll
            for (int ai = 0; ai < 2; ++ai)
#pragma unroll
                for (int m = 0; m < 4; ++m) { const int row = rbase + ai * HALF + m * 16;
                    if (row < ROWS_T) { f32x4 o[2];
#pragma unroll
                        for (int n = 0; n < 2; ++n) { const f32x4 a = acc[ai][0][m][n], g = acc[ai][1][m][n];
#pragma unroll
                            for (int e = 0; e < 4; ++e) o[n][e] = a[e] * sigmoidf_fast(g[e]); }
                        *(u32x4*)(Ub + (size_t)row * 1024 + ch) = pack8(o[0], o[1]); } }
        }
    }
};
struct EpiPlain {
    static constexpr bool PERM = true, AFTER_DRAIN = false;
    bf16_t* O; int ldc;
    __device__ __forceinline__ void operator()(const f32x4 (&acc)[2][2][4][2], const Unit& u, int wr, int wc, int fr, int fq) const {
        const int rbase = u.pm * BM + wr * 64 + fr, col0 = u.pn * BM + wc * 32 + 8 * fq;
#pragma unroll
        for (int ai = 0; ai < 2; ++ai)
#pragma unroll
            for (int m = 0; m < 4; ++m) { const int row = rbase + ai * HALF + m * 16;
                if (row < ROWS_T) {
#pragma unroll
                    for (int bj = 0; bj < 2; ++bj) *(u32x4*)(O + (size_t)row * ldc + col0 + bj * HALF) = pack8(acc[ai][bj][m][0], acc[ai][bj][m][1]); } }
    }
};
struct EpiSwiGLU {
    static constexpr bool PERM = true, AFTER_DRAIN = false;
    bf16_t* O; int ldc;
    __device__ __forceinline__ void operator()(const f32x4 (&acc)[2][2][4][2], const Unit& u, int wr, int wc, int fr, int fq) const {
        const int rbase = u.pm * BM + wr * 64 + fr, col0 = u.pn * 128 + wc * 32 + 8 * fq;
#if defined(PROBE_DUP) && PROBE_DUP == 80
        for (int rep_ = 0; rep_ < 2; ++rep_) { asm volatile("" ::: "memory");
#endif
#pragma unroll
        for (int ai = 0; ai < 2; ++ai)
#pragma unroll
            for (int m = 0; m < 4; ++m) { const int row = rbase + ai * HALF + m * 16;
                if (row < ROWS_T) { f32x4 o[2];
#pragma unroll
                    for (int n = 0; n < 2; ++n) { const f32x4 g = acc[ai][0][m][n], up = acc[ai][1][m][n];
#pragma unroll
                        for (int e = 0; e < 4; ++e) o[n][e] = g[e] * sigmoidf_fast(g[e]) * up[e]; }
                    *(u32x4*)(O + (size_t)row * ldc + col0) = pack8(o[0], o[1]); } }
#if defined(PROBE_DUP) && PROBE_DUP == 80
        }
#endif
    }
};
template <class Epi, class Sched, bool ALIGN_EPI = false, bool SP2 = false>
__device__ __forceinline__ void gemm_phase(PG8_LAS unsigned char* lds, const Gemm g, const Sched& S, const Epi& E, int tid_in) {
    int tid_ = tid_in; asm volatile("" : "+v"(tid_));
    const int tid = tid_, wid = __builtin_amdgcn_readfirstlane(tid >> 6), lane = tid & 63, wr = wid >> 2, wc = wid & 3, fr = lane & 15, fq = lane >> 4;
    const int K = g.K, nt = K / BK;
    unsigned voffA[2], voffB[2];
#pragma unroll
    for (int i = 0; i < 2; ++i) { int R, C; stage_rc(tid * 16 + i * 8192, R, C); const int Rb = Epi::PERM ? ((R & ~31) + perm32(R & 31)) : R;
        voffA[i] = (unsigned)(R * K + C) * 2u; voffB[i] = (unsigned)(Rb * K + C) * 2u; }
    const size_t kstep = (size_t)(BK * 2);
    const size_t hstep = (size_t)HALF * K * 2;
    const size_t tstep = 2 * hstep;
    const unsigned ldsw = (unsigned)wid * 1024u;
    const int aoff = lds_byte(wr * 64 + fr, fq * 8), boff = lds_byte(wc * 32 + fr, fq * 8);
#define PG8_SA(b, h) (((b) * 2 + (h)) * HTB)
#define PG8_SB(b, h) ((4 + (b) * 2 + (h)) * HTB)
#define PG8_STAGE(bufoff, gbase, voff) do { _Pragma("unroll") for (int _i = 0; _i < 2; ++_i) \
        __builtin_amdgcn_global_load_lds((const unsigned*)((const char*)(gbase) + (voff)[_i]), (PG8_LAS unsigned*)(lds + (bufoff) + ldsw + _i * 8192), 16, 0, 0); } while (0)
#define PG8_LDA(dst, b, h) do { _Pragma("unroll") for (int m = 0; m < 4; ++m) _Pragma("unroll") for (int k = 0; k < 2; ++k) dst[m][k] = *(const PG8_LAS bf16x8*)(lds + PG8_SA(b, h) + aoff + m * 2048 + k * 1024); } while (0)
#define PG8_LDB(dst, b, h) do { _Pragma("unroll") for (int n = 0; n < 2; ++n) _Pragma("unroll") for (int k = 0; k < 2; ++k) dst[n][k] = *(const PG8_LAS bf16x8*)(lds + PG8_SB(b, h) + boff + n * 2048 + k * 1024); } while (0)
#define PG8_MMA(ai, bj, At, Bt) do { __builtin_amdgcn_s_setprio(1); _Pragma("unroll") for (int m = 0; m < 4; ++m) _Pragma("unroll") for (int n = 0; n < 2; ++n) _Pragma("unroll") for (int k = 0; k < 2; ++k) \
        acc[ai][bj][m][n] = __builtin_amdgcn_mfma_f32_16x16x32_bf16(Bt[n][k], At[m][k], acc[ai][bj][m][n], 0, 0, 0); __builtin_amdgcn_s_setprio(0); } while (0)
#define PG8_WAIT_V(n) asm volatile("s_waitcnt vmcnt(" #n ")" ::: "memory")
#define PG8_WAIT_L(n) asm volatile("s_waitcnt lgkmcnt(" #n ")" ::: "memory")
#define PG8_BAR __builtin_amdgcn_s_barrier()
#define PG8_SCHED __builtin_amdgcn_sched_barrier(0)
    Unit cur, nxt; int ui = 0;
    if (!S.next(0, cur)) return;
    f32x4 acc[2][2][4][2];
#pragma unroll
    for (int a = 0; a < 2; ++a)
#pragma unroll
        for (int b = 0; b < 2; ++b)
#pragma unroll
            for (int m = 0; m < 4; ++m)
#pragma unroll
                for (int n = 0; n < 2; ++n) acc[a][b][m][n] = (f32x4){0.f, 0.f, 0.f, 0.f};
    bf16x8 At[4][2], B0[2][2], B1[2][2];
    const char* cA = (const char*)g.A + (size_t)cur.pm * tstep; const char* cB = (const char*)g.Bt + (size_t)cur.pn * tstep;
    S.a_ready(cur);
    if constexpr (SP2) {
        PG8_STAGE(PG8_SB(0, 0), cB, voffB); PG8_STAGE(PG8_SB(0, 1), cB + hstep, voffB); PG8_STAGE(PG8_SA(0, 0), cA, voffA); PG8_STAGE(PG8_SA(0, 1), cA + hstep, voffA);
        if (wr == 1) PG8_BAR;
        PG8_WAIT_V(2); PG8_BAR;
        PG8_STAGE(PG8_SB(1, 0), cB + kstep, voffB); PG8_STAGE(PG8_SA(1, 0), cA + kstep, voffA); PG8_STAGE(PG8_SB(1, 1), cB + hstep + kstep, voffB);
        PG8_WAIT_V(6); PG8_BAR;
    } else {
        PG8_STAGE(PG8_SB(0, 0), cB, voffB); PG8_STAGE(PG8_SA(0, 0), cA, voffA); PG8_STAGE(PG8_SB(0, 1), cB + hstep, voffB); PG8_STAGE(PG8_SA(0, 1), cA + hstep, voffA);
        if (wr == 1) PG8_BAR;
        PG8_WAIT_V(4); PG8_BAR;
        PG8_STAGE(PG8_SB(1, 0), cB + kstep, voffB); PG8_STAGE(PG8_SA(1, 0), cA + kstep, voffA); PG8_STAGE(PG8_SB(1, 1), cB + hstep + kstep, voffB);
        PG8_WAIT_V(6); PG8_BAR;
    }
    for (;;) {
        const bool has_next = S.next(ui + 1, nxt);
        const char* nA = has_next ? (const char*)g.A + (size_t)nxt.pm * tstep : cA; const char* nB = has_next ? (const char*)g.Bt + (size_t)nxt.pn * tstep : cB;
        for (int t = 0; t < nt; t += 2) {
            const bool last = (t == nt - 2);
            const char* a1 = cA + (size_t)(t + 1) * kstep;
            const char* a2 = last ? nA : cA + (size_t)(t + 2) * kstep; const char* b2 = last ? nB : cB + (size_t)(t + 2) * kstep;
            const char* a3 = a2 + kstep; const char* b3 = b2 + kstep;
            if (last && has_next) S.a_ready(nxt);
            if constexpr (SP2) {
            PG8_LDB(B0, 0, 0); PG8_LDB(B1, 0, 1); PG8_SCHED; PG8_LDA(At, 0, 0); PG8_STAGE(PG8_SA(1, 1), a1 + hstep, voffA);
            PG8_WAIT_V(8); PG8_WAIT_L(0); PG8_BAR; PG8_MMA(0, 0, At, B0); PG8_MMA(0, 1, At, B1); PG8_BAR; PG8_SCHED;
            PG8_LDA(At, 0, 1); PG8_STAGE(PG8_SB(0, 0), b2, voffB); PG8_STAGE(PG8_SB(0, 1), b2 + hstep, voffB); PG8_STAGE(PG8_SA(0, 0), a2, voffA);
            PG8_WAIT_V(8); PG8_WAIT_L(0); PG8_BAR; PG8_MMA(1, 0, At, B0); PG8_MMA(1, 1, At, B1); PG8_BAR; PG8_SCHED;
            PG8_LDB(B0, 1, 0); PG8_LDB(B1, 1, 1); PG8_SCHED; PG8_LDA(At, 1, 0); PG8_STAGE(PG8_SA(0, 1), a2 + hstep, voffA);
            PG8_WAIT_V(8); PG8_WAIT_L(0); PG8_BAR; PG8_MMA(0, 0, At, B0); PG8_MMA(0, 1, At, B1); PG8_BAR; PG8_SCHED;
            PG8_LDA(At, 1, 1); PG8_STAGE(PG8_SB(1, 0), b3, voffB); PG8_STAGE(PG8_SB(1, 1), b3 + hstep, voffB); PG8_STAGE(PG8_SA(1, 0), a3, voffA);
            PG8_WAIT_V(8); PG8_WAIT_L(0); PG8_BAR; PG8_MMA(1, 0, At, B0); PG8_MMA(1, 1, At, B1); PG8_BAR; PG8_SCHED;
            } else {
            PG8_LDB(B0, 0, 0); PG8_SCHED; PG8_LDA(At, 0, 0); PG8_STAGE(PG8_SA(1, 1), a1 + hstep, voffA);
            PG8_WAIT_L(8); PG8_BAR; PG8_WAIT_L(0); PG8_MMA(0, 0, At, B0); PG8_BAR; PG8_SCHED;
            PG8_LDB(B1, 0, 1); PG8_STAGE(PG8_SB(0, 0), b2, voffB);
            PG8_BAR; PG8_WAIT_L(0); PG8_MMA(0, 1, At, B1); PG8_BAR;
            PG8_LDA(At, 0, 1); PG8_STAGE(PG8_SA(0, 0), a2, voffA);
            PG8_BAR; PG8_WAIT_L(0); PG8_MMA(1, 0, At, B0); PG8_BAR; PG8_SCHED;
            PG8_STAGE(PG8_SB(0, 1), b2 + hstep, voffB);
            PG8_WAIT_V(6); PG8_BAR; PG8_MMA(1, 1, At, B1); PG8_BAR;
            PG8_LDB(B0, 1, 0); PG8_SCHED; PG8_LDA(At, 1, 0); PG8_STAGE(PG8_SA(0, 1), a2 + hstep, voffA);
            PG8_WAIT_L(8); PG8_BAR; PG8_WAIT_L(0); PG8_MMA(0, 0, At, B0); PG8_BAR; PG8_SCHED;
            PG8_LDB(B1, 1, 1); PG8_STAGE(PG8_SB(1, 0), b3, voffB);
            PG8_BAR; PG8_WAIT_L(0); PG8_MMA(0, 1, At, B1); PG8_BAR;
            PG8_LDA(At, 1, 1); PG8_STAGE(PG8_SA(1, 0), a3, voffA);
            PG8_BAR; PG8_WAIT_L(0); PG8_MMA(1, 0, At, B0); PG8_BAR; PG8_SCHED;
            PG8_STAGE(PG8_SB(1, 1), b3 + hstep, voffB);
            PG8_WAIT_V(6); PG8_BAR; PG8_MMA(1, 1, At, B1); PG8_BAR;
            }
        }
        if constexpr (ALIGN_EPI) { if (wr == 0) PG8_BAR; }
        if constexpr (!Epi::AFTER_DRAIN) { E(acc, cur, wr, wc, fr, fq); S.done(cur); }
        if (!has_next) break;
#pragma unroll
        for (int a = 0; a < 2; ++a)
#pragma unroll
            for (int b = 0; b < 2; ++b)
#pragma unroll
                for (int m = 0; m < 4; ++m)
#pragma unroll
                    for (int n = 0; n < 2; ++n) acc[a][b][m][n] = (f32x4){0.f, 0.f, 0.f, 0.f};
        cur = nxt; cA = nA; cB = nB; ++ui;
        if constexpr (ALIGN_EPI) { if (wr == 1) PG8_BAR; }
    }
    PG8_WAIT_V(0);
    if constexpr (!ALIGN_EPI) { if (wr == 0) PG8_BAR; }
    PG8_BAR;
    if constexpr (Epi::AFTER_DRAIN) { E.fused(acc, cur, wr, wc, fr, fq, lds, wid, lane); S.done(cur); }
#undef PG8_SA
#undef PG8_SB
#undef PG8_STAGE
#undef PG8_LDA
#undef PG8_LDB
#undef PG8_MMA
#undef PG8_WAIT_V
#undef PG8_WAIT_L
#undef PG8_BAR
#undef PG8_SCHED
}
}
constexpr int NWAVES = 8;
constexpr int D = 2048, SEQ = 2048, MP = 8192, MS = 64, MT = MP + MS, MPAD = 8448, DEPTH = 4;
constexpr int AW = 1024, NH = 16, HD = 64, CCH = 1024, CK = 31, NIN = 5120, DFF = 5632, NGU = 2 * DFF, NMOD = 6 * D, WBUF = 2048, NBR = 12;
constexpr float EPS = 1e-6f;
constexpr float LOG2E = 1.4426950408889634f;
constexpr float QSCALE = 0.125f * LOG2E;
enum { I_XP = 0, I_XS, I_CP, I_CS, I_CK, I_CV, I_SC, I_GPM, I_GQM, I_GPF, I_GQF, I_WMOD, I_BMOD, I_WIN, I_GAO, I_CW, I_CB, I_LNG, I_LNB, I_WOUT, I_WGU, I_WDN, N_IN };
constexpr size_t O_YP = 0, O_YS = 16777216, O_KP = 16908288, O_VP = 50462720, O_CP = 84017152, O_KS = 84508672, O_VS = 151617536, O_CS = 218726400, O_END = 219709440;
constexpr size_t MiB = 1u << 20;
constexpr size_t WS_CTL = 0, CTL_ZERO_BYTES = 1 * MiB;
constexpr size_t SZ_WIN = (size_t)NIN * D * 2, SZ_WOUT = (size_t)D * D * 2, SZ_WGU = (size_t)NGU * D * 2, SZ_WDN = (size_t)D * DFF * 2;
constexpr size_t WS_WIN = 1 * MiB, WS_WOUT = WS_WIN + DEPTH * SZ_WIN, WS_WGU = WS_WOUT + DEPTH * SZ_WOUT, WS_WDN = WS_WGU + DEPTH * SZ_WGU;
constexpr size_t WS_XRES = WS_WDN + DEPTH * SZ_WDN;
constexpr size_t WS_H = WS_XRES + 65 * MiB;
constexpr size_t WS_Q = WS_H + 33 * MiB, WS_K = WS_Q + 17 * MiB, WS_V = WS_K + 17 * MiB, WS_U = WS_V + 17 * MiB;
constexpr size_t WS_O32 = WS_U + 17 * MiB;
constexpr size_t WS_MIXIN = WS_O32 + 33 * MiB;
constexpr size_t WS_MIX = WS_MIXIN + 33 * MiB;
constexpr size_t WS_FACT = WS_MIX + 33 * MiB;
constexpr size_t WS_F = WS_FACT + 91 * MiB;
constexpr size_t WS_SKP = WS_F + 33 * MiB;
constexpr size_t WS_MODP = WS_SKP + 2 * MiB;
constexpr size_t WS_MOD = WS_MODP + 36 * MiB;
constexpr size_t WS_OB = WS_MOD + 3 * MiB;
constexpr size_t WS_LSE = WS_OB + 49 * MiB;
constexpr size_t WS_YPRE = WS_LSE + 2 * MiB;
constexpr size_t WS_END = WS_YPRE + 17 * MiB;
static_assert(SZ_WIN == 20 * MiB && SZ_WOUT == 8 * MiB && SZ_WGU == 44 * MiB && SZ_WDN == 22 * MiB, "weight sizes");
static_assert((size_t)MT * D * 4 <= 65 * MiB && (size_t)MPAD * D * 2 <= 33 * MiB && (size_t)MPAD * 1024 * 2 <= 17 * MiB && (size_t)MT * 1024 * 4 <= 33 * MiB && (size_t)MPAD * DFF * 2 <= 91 * MiB, "ws map");
static_assert((size_t)16 * DEPTH * 12 * NMOD * 4 <= 36 * MiB && (size_t)DEPTH * 12 * NMOD * 4 <= 3 * MiB, "ws map 2");
constexpr int CW_BAR = 4096;
constexpr int RING_OFF = 0, RING_BYTES = 131072;
constexpr int LDSCTL_OFF = RING_BYTES, MISC_OFF = LDSCTL_OFF + 320;
constexpr int LDS_BYTES = 147456;

#define GAS __attribute__((address_space(1)))
#define LAS __attribute__((address_space(3)))
typedef unsigned short bf16;
typedef unsigned v4u __attribute__((ext_vector_type(4)));
typedef unsigned v2u __attribute__((ext_vector_type(2)));
typedef float f32x4 __attribute__((ext_vector_type(4)));
typedef float f32x2 __attribute__((ext_vector_type(2)));
typedef float f32x16 __attribute__((ext_vector_type(16)));
typedef short bf16x8 __attribute__((ext_vector_type(8)));
typedef GAS unsigned gu32;
#define RLX_AGENT __ATOMIC_RELAXED, __HIP_MEMORY_SCOPE_AGENT
#define LDS_WAIT() asm volatile("s_waitcnt lgkmcnt(0)" ::: "memory")
#define VM_WAIT() asm volatile("s_waitcnt vmcnt(0)" ::: "memory")
__device__ __forceinline__ unsigned f2bf(float f) { unsigned u = __builtin_bit_cast(unsigned, f); return (u + 0x7fffu + ((u >> 16) & 1u)) >> 16; }
__device__ __forceinline__ unsigned pk2(float lo, float hi) { return f2bf(lo) | (f2bf(hi) << 16); }
__device__ __forceinline__ float bflo(unsigned u) { return __builtin_bit_cast(float, u << 16); }
__device__ __forceinline__ float bfhi(unsigned u) { return __builtin_bit_cast(float, u & 0xffff0000u); }
__device__ __forceinline__ float sigm(float x) { return __builtin_amdgcn_rcpf(1.0f + __builtin_amdgcn_exp2f(-LOG2E * x)); }
#define XB_TMO      128
#define XB_XCNT(j)  (256  + 64 * (j))
#define XB_XSUB(j)  (1280 + 64 * (j))
#define XB_XGEN(j)  (2304 + 64 * (j))
#define XB_TOP      3328
#define XB_TOPGEN   3392
#define XCD_BAR_WORDS 3456
#define XB_SPIN_CAP (1u << 18)

__device__ __forceinline__ unsigned xb_ld(unsigned* p)              { return __hip_atomic_load(p, __ATOMIC_RELAXED, __HIP_MEMORY_SCOPE_AGENT); }
__device__ __forceinline__ unsigned xb_add(unsigned* p, unsigned v) { return __hip_atomic_fetch_add(p, v, __ATOMIC_RELAXED, __HIP_MEMORY_SCOPE_AGENT); }
__device__ __forceinline__ unsigned xb_xcc_id() { return (unsigned)__builtin_amdgcn_s_getreg((3 << 11) | 20) & 0xFu; }
#define XB_SPIN(cond, bar) do { unsigned _sp = 0; while (cond) { __builtin_amdgcn_s_sleep(1); \
    if ((++_sp & 255u) == 0u) { if (xb_ld(&(bar)[XB_TMO])) break; if (_sp > XB_SPIN_CAP) { atomicAdd(&(bar)[XB_TMO], 1u); break; } } } } while (0)

struct XcdBarrier {
    unsigned* bar; unsigned x;
    volatile LAS unsigned* st;
};

__device__ __forceinline__ XcdBarrier xcd_barrier_post(unsigned* bar, volatile LAS unsigned* st) {
    XcdBarrier b; b.bar = bar; b.x = xb_xcc_id(); b.st = st;
    if (threadIdx.x == 0) (void)xb_add(&bar[XB_XCNT(b.x)], 1u);
    return b;
}
__device__ __forceinline__ void xcd_barrier_complete(unsigned* bar, unsigned x, unsigned& nloc, unsigned& nx) {
    const unsigned G = gridDim.x * gridDim.y * gridDim.z;
    unsigned sum, cnt, mine, sp = 0u;
    for (;;) {
        sum = 0u; cnt = 0u; mine = 0u;
#pragma unroll
        for (unsigned j = 0; j < 16; ++j) { const unsigned c = xb_ld(&bar[XB_XCNT(j)]); sum += c; cnt += (c > 0u) ? 1u : 0u; mine = (j == x) ? c : mine; }
        if (sum == G) break;
        __builtin_amdgcn_s_sleep(1);
        if ((++sp & 255u) == 0u) { if (xb_ld(&bar[XB_TMO])) break; if (sp > XB_SPIN_CAP) { atomicAdd(&bar[XB_TMO], 1u); break; } }
    }
    nloc = mine > 0u ? mine : 1u; nx = cnt > 0u ? cnt : 1u;
}

__device__ __forceinline__ void xcd_barrier(const XcdBarrier& b) {
    asm volatile("s_waitcnt vmcnt(0)" ::: "memory");
    __syncthreads();
    if (threadIdx.x == 0) {
        unsigned* bar = b.bar; unsigned bx = b.x; asm volatile("" : "+s"(bx));
        __builtin_amdgcn_s_waitcnt(0);
        unsigned nloc = b.st[0], nx = b.st[1];
        if (nloc == 0u) { xcd_barrier_complete(bar, bx, nloc, nx); b.st[0] = nloc; b.st[1] = nx; }
        const unsigned old = xb_add(&bar[XB_XSUB(bx)], 1u);
        const unsigned gen = old / nloc;
        if (old + 1u == (gen + 1u) * nloc) {
            __builtin_amdgcn_fence(__ATOMIC_RELEASE, "agent");
            asm volatile("s_waitcnt vmcnt(0)" ::: "memory");
            const unsigned og = xb_add(&bar[XB_TOP], 1u);
            const unsigned tg = og / nx;
            if (og + 1u == (tg + 1u) * nx) xb_add(&bar[XB_TOPGEN], 1u);
            else XB_SPIN(xb_ld(&bar[XB_TOPGEN]) == tg, bar);
            __builtin_amdgcn_fence(__ATOMIC_ACQUIRE, "agent");
            xb_add(&bar[XB_XGEN(bx)], 1u);
            asm volatile("s_waitcnt vmcnt(0)" ::: "memory");
        } else {
            XB_SPIN(xb_ld(&bar[XB_XGEN(bx)]) == gen, bar);
            __builtin_amdgcn_fence(__ATOMIC_ACQUIRE, "agent");
            asm volatile("s_waitcnt vmcnt(0)" ::: "memory");
        }
    }
    __syncthreads();
}

struct Frame {
    LAS unsigned char* lds;
    volatile LAS unsigned* MISC;
    gu32* ctl;
    int tid, lane, wave, G, bid;
    float* out; unsigned char* ws;
};
__device__ __forceinline__ const float* inp_(const Frame& F, int i) {
    const LAS unsigned* p = (const LAS unsigned*)(F.lds + LDSCTL_OFF) + 2 * i; const unsigned lo = __builtin_amdgcn_readfirstlane(p[0]), hi = __builtin_amdgcn_readfirstlane(p[1]);
    return (const float*)(const GAS float*)(((unsigned long long)hi << 32) | lo);
}
#define INP(i) inp_(F, (i))
__device__ __forceinline__ int launder(int v) { asm volatile("" : "+v"(v)); return v; }
__device__ __forceinline__ int lane_id_now() { int l; asm volatile("v_mbcnt_lo_u32_b32 %0, -1, 0\n\tv_mbcnt_hi_u32_b32 %0, -1, %0" : "=v"(l)); return l; }
__device__ __forceinline__ float wave_sum(float v) {
#pragma unroll
    for (int o = 1; o < 64; o <<= 1) v += __shfl_xor(v, o);
    return v;
}
__device__ __forceinline__ float wave_max(float v) {
#pragma unroll
    for (int o = 1; o < 64; o <<= 1) v = fmaxf(v, __shfl_xor(v, o));
    return v;
}
__device__ __forceinline__ int batch_row(int m) { return m < MP ? (m >> 11) : 4 + ((m - MP) >> 3); }

__device__ __forceinline__ int map_win(int n) { if (n < 3072) return n; if (n < 4096) { const int c = n - 3072; return 3072 + 256 * (c >> 7) + (c & 127); } const int c = n - 4096; return 3072 + 256 * (c >> 7) + 128 + (c & 127); }
__device__ __forceinline__ int map_wgu(int n) { if (n < DFF) return 256 * (n >> 7) + (n & 127); const int c = n - DFF; return 256 * (c >> 7) + 128 + (c & 127); }
template <int MAP>
__device__ __forceinline__ void p0_transpose_item(const float* W, int K, int N, bf16* WT, LAS float* scr, int item, int lane) {
    const int nblk = N / 32, kb = item / nblk, nb = item % nblk, k0 = 64 * kb, n0 = 32 * nb;
    const int d0 = MAP == 1 ? map_win(n0) : (MAP == 2 ? map_wgu(n0) : n0);
    f32x4 wv[8];
#pragma unroll
    for (int i = 0; i < 8; ++i) wv[i] = __builtin_nontemporal_load((const f32x4*)(W + (size_t)(k0 + 8 * i + (lane >> 3)) * N + n0 + 4 * (lane & 7)));
#pragma unroll
    for (int i = 0; i < 8; ++i) { LAS float* d = scr + (8 * i + (lane >> 3)) * 33 + 4 * (lane & 7); d[0] = wv[i].x; d[1] = wv[i].y; d[2] = wv[i].z; d[3] = wv[i].w; }
    LDS_WAIT(); asm volatile("" ::: "memory");
    const int c = lane & 7;
#pragma unroll
    for (int j = 0; j < 4; ++j) { const int n = (lane >> 3) + 8 * j; const LAS float* s = scr + (8 * c) * 33 + n;
        v4u o; o.x = pk2(s[0 * 33], s[1 * 33]); o.y = pk2(s[2 * 33], s[3 * 33]); o.z = pk2(s[4 * 33], s[5 * 33]); o.w = pk2(s[6 * 33], s[7 * 33]);
        *(GAS v4u*)(WT + (size_t)(d0 + n) * K + k0 + 8 * c) = o; }
    LDS_WAIT(); asm volatile("" ::: "memory");
}
__device__ __forceinline__ void p0_transposes(Frame& F) {
    LAS float* scr = (LAS float*)(F.lds + RING_OFF + F.wave * 16384);
    const int gw = F.bid * NWAVES + F.wave, NGW = F.G * NWAVES;
    constexpr int I_IN = (D / 64) * (NIN / 32), I_OUT = (D / 64) * (D / 32), I_GU = (D / 64) * (NGU / 32), I_DN = (DFF / 64) * (D / 32), I_L = I_IN + I_OUT + I_GU + I_DN;
    for (int it = gw; it < DEPTH * I_L; it += NGW) {
        const int l = it / I_L; int r = it % I_L;
        if (r < I_IN) { p0_transpose_item<1>(INP(I_WIN) + (size_t)l * D * NIN, D, NIN, (bf16*)(F.ws + WS_WIN + l * SZ_WIN), scr, r, F.lane); continue; } r -= I_IN;
        if (r < I_OUT) { p0_transpose_item<0>(INP(I_WOUT) + (size_t)l * D * D, D, D, (bf16*)(F.ws + WS_WOUT + l * SZ_WOUT), scr, r, F.lane); continue; } r -= I_OUT;
        if (r < I_GU) { p0_transpose_item<2>(INP(I_WGU) + (size_t)l * D * NGU, D, NGU, (bf16*)(F.ws + WS_WGU + l * SZ_WGU), scr, r, F.lane); continue; } r -= I_GU;
        p0_transpose_item<0>(INP(I_WDN) + (size_t)l * DFF * D, DFF, D, (bf16*)(F.ws + WS_WDN + l * SZ_WDN), scr, r, F.lane);
    }
}
__device__ __forceinline__ void p0_mod_partials(Frame& F) {
    LAS float* cs = (LAS float*)(F.lds + RING_OFF);
    float* modp = (float*)(F.ws + WS_MODP);
    for (int it = F.bid; it < DEPTH * 16 * 6; it += F.G) {
        const int l = it / 96, kc = (it % 96) / 6, nb = it % 6, k0 = kc * 128;
        __syncthreads();
        for (int e = F.tid; e < 12 * 128; e += 512) { const int r = e >> 7, k = e & 127; const float c = r < 4 ? INP(I_CP)[r * D + k0 + k] : INP(I_CS)[(r - 4) * D + k0 + k]; cs[e] = c * sigm(c); }
        __syncthreads();
        const int n = nb * 2048 + F.tid * 4;
        const float* w = INP(I_WMOD) + ((size_t)l * D + k0) * NMOD + n;
        f32x4 acc[12];
#pragma unroll
        for (int r = 0; r < 12; ++r) acc[r] = (f32x4){0.f, 0.f, 0.f, 0.f};
#pragma unroll 4
        for (int k = 0; k < 128; ++k) { const f32x4 wv = __builtin_nontemporal_load((const f32x4*)(w + (size_t)k * NMOD));
#pragma unroll
            for (int r = 0; r < 12; ++r) acc[r] += wv * cs[r * 128 + k]; }
#pragma unroll
        for (int r = 0; r < 12; ++r) *(f32x4*)(modp + (((size_t)kc * DEPTH + l) * 12 + r) * NMOD + n) = acc[r];
    }
    __syncthreads();
}
__device__ __forceinline__ void p0_cache_copy(Frame& F) {
    const size_t nth = (size_t)F.G * 512, gt = (size_t)F.bid * 512 + F.tid;
    constexpr size_t BLK = (size_t)2040 * 1024 / 4;
    { const f32x4* src = (const f32x4*)INP(I_CK); f32x4* dst = (f32x4*)(F.out + O_KS);
        for (size_t i = gt; i < (size_t)32 * BLK; i += nth) { const size_t blk = i / BLK, off = i % BLK;
            const f32x4 v = __builtin_nontemporal_load(src + blk * (2048 * 256) + 8 * 256 + off);
            __builtin_nontemporal_store(v, dst + blk * (2048 * 256) + off); } }
    { const f32x4* src = (const f32x4*)INP(I_CV); f32x4* dst = (f32x4*)(F.out + O_VS);
        for (size_t i = gt; i < (size_t)32 * BLK; i += nth) { const size_t blk = i / BLK, off = i % BLK;
            const f32x4 v = __builtin_nontemporal_load(src + blk * (2048 * 256) + 8 * 256 + off);
            __builtin_nontemporal_store(v, dst + blk * (2048 * 256) + off); } }
}
constexpr int TAIL_SLOTS = 192, TAIL_F4 = 43520, BLK_F4 = 522240;
static_assert((long)TAIL_SLOTS * TAIL_F4 == 16L * BLK_F4, "tail copy slots cover the layer's window copy exactly");
__device__ __forceinline__ void tail_copy(Frame& F, int l, int slot) {
    const f32x4* sk = (const f32x4*)INP(I_CK); const f32x4* sv = (const f32x4*)INP(I_CV); f32x4* dk = (f32x4*)(F.out + O_KS); f32x4* dv = (f32x4*)(F.out + O_VS);
    const int tid = F.tid;
    for (int k0 = 0; k0 < TAIL_F4 / 512; k0 += 17) {
        f32x4 v[17]; size_t dofs[17]; int ts[17];
#pragma unroll
        for (int k = 0; k < 17; ++k) {
            const int i = slot * TAIL_F4 + (k0 + k) * 512 + tid, t = i / (8 * BLK_F4), rem = i % (8 * BLK_F4), blk = rem / BLK_F4, off = rem % BLK_F4;
            const size_t so = ((size_t)(l * 8 + blk) * 2048 + 8) * 256 + off; dofs[k] = (size_t)(l * 8 + blk) * 2048 * 256 + off; ts[k] = t;
            v[k] = __builtin_nontemporal_load((t ? sv : sk) + so);
        }
        __builtin_amdgcn_sched_barrier(0);
#pragma unroll
        for (int k = 0; k < 17; ++k) __builtin_nontemporal_store(v[k], (ts[k] ? dv : dk) + dofs[k]);
    }
}
__device__ __forceinline__ void p0_mod_reduce(Frame& F) {
    const float* modp = (const float*)(F.ws + WS_MODP); bf16* modb = (bf16*)(F.ws + WS_MOD);
    const int total = DEPTH * 12 * NMOD / 4;
    for (int i = F.bid * 512 + F.tid; i < total; i += F.G * 512) {
        const int e = i * 4, l = e / (12 * NMOD), n = e % NMOD, ch = n >> 11, c = n & 2047;
        f32x4 s = *(const f32x4*)(INP(I_BMOD) + (size_t)l * NMOD + n);
#pragma unroll
        for (int kc = 0; kc < 16; ++kc) s += *(const f32x4*)(modp + (size_t)kc * DEPTH * 12 * NMOD + e);
        if (ch == 1) s = (s + 1.0f) * *(const f32x4*)(INP(I_GPM) + (size_t)l * D + c);
        else if (ch == 2) s = s * *(const f32x4*)(INP(I_GQM) + (size_t)l * D + c);
        else if (ch == 4) s = (s + 1.0f) * *(const f32x4*)(INP(I_GPF) + (size_t)l * D + c);
        else if (ch == 5) s = s * *(const f32x4*)(INP(I_GQF) + (size_t)l * D + c);
        v2u w; w.x = pk2(s.x, s.y); w.y = pk2(s.z, s.w); *(v2u*)(modb + e) = w;
    }
}
#define UNP(v) ((f32x4){bflo((v).x), bfhi((v).x), bflo((v).y), bfhi((v).y)})
template <bool HAS_DELTA, bool XIN_F32, bool PROMPT = true>
__device__ __forceinline__ void resnorm_rows(Frame& F, const float* xin_p, const float* xin_s, float* out32_p, float* out32_s, const bf16* dbf, const float* dpart,
                                             const bf16* mgate, const bf16* msc, const bf16* msh, bf16* hb, unsigned* sig = nullptr) {
    bf16* XR = (bf16*)(F.ws + WS_XRES);
    const int gw = F.bid * NWAVES + F.wave, lane = F.lane;
    if (PROMPT) for (int m0 = 4 * gw; m0 < MP; m0 += 4 * F.G * NWAVES) {
        const int br = m0 >> 11;
        v4u v1[4], v2[4], v3[4];
#pragma unroll
        for (int j = 0; j < 4; ++j) { const int c = 8 * lane + 512 * j;
            if (HAS_DELTA) v1[j] = *(const v4u*)(mgate + (size_t)br * NMOD + c);
            if (hb) { v2[j] = *(const v4u*)(msc + (size_t)br * NMOD + c); v3[j] = *(const v4u*)(msh + (size_t)br * NMOD + c); } }
        f32x4 xf[2][4][2]; v4u xq[2][4], dq[2][4];
#define UNL(v) ((f32x4){bflo((v).x), bfhi((v).x), bflo((v).y), bfhi((v).y)})
#define UNH(v) ((f32x4){bflo((v).z), bfhi((v).z), bflo((v).w), bfhi((v).w)})
#define LOADROW(buf, mm) do { _Pragma("unroll") for (int j = 0; j < 4; ++j) { const size_t o_ = (size_t)(mm) * D + 8 * lane + 512 * j; \
            if (XIN_F32) { xf[buf][j][0] = __builtin_nontemporal_load((const f32x4*)(xin_p + o_)); xf[buf][j][1] = __builtin_nontemporal_load((const f32x4*)(xin_p + o_ + 4)); } \
            else xq[buf][j] = __builtin_nontemporal_load((const v4u*)(XR + o_)); \
            if (HAS_DELTA) dq[buf][j] = __builtin_nontemporal_load((const v4u*)(dbf + o_)); } } while (0)
        LOADROW(0, m0);
#pragma unroll
        for (int i = 0; i < 4; ++i) {
            const int m = m0 + i, cur = i & 1;
            if (i < 3) LOADROW(cur ^ 1, m + 1);
            __builtin_amdgcn_sched_barrier(0);
#pragma unroll
            for (int j = 0; j < 4; ++j) { asm volatile("" : "+v"(v1[j]), "+v"(v2[j]), "+v"(v3[j])); }
            f32x4 x[4][2];
#pragma unroll
            for (int j = 0; j < 4; ++j) { x[j][0] = XIN_F32 ? xf[cur][j][0] : UNL(xq[cur][j]); x[j][1] = XIN_F32 ? xf[cur][j][1] : UNH(xq[cur][j]); }
            if (HAS_DELTA) {
                float ss = 0.f;
#pragma unroll
                for (int j = 0; j < 4; ++j) { const f32x4 t = UNL(dq[cur][j]), u = UNH(dq[cur][j]); ss += ((t.x * t.x + t.y * t.y) + (t.z * t.z + t.w * t.w)) + ((u.x * u.x + u.y * u.y) + (u.z * u.z + u.w * u.w)); }
                const float r = 1.0f / sqrtf(wave_sum(ss) * (1.0f / D) + EPS);
#pragma unroll
                for (int j = 0; j < 4; ++j) { x[j][0] = x[j][0] + UNL(v1[j]) * (UNL(dq[cur][j]) * r); x[j][1] = x[j][1] + UNH(v1[j]) * (UNH(dq[cur][j]) * r); }
            }
            if (out32_p) {
#pragma unroll
                for (int j = 0; j < 4; ++j) { float* o = out32_p + (size_t)m * D + 8 * lane + 512 * j; *(f32x4*)o = x[j][0]; *(f32x4*)(o + 4) = x[j][1]; }
            } else {
#pragma unroll
                for (int j = 0; j < 4; ++j) { v4u w; w.x = pk2(x[j][0].x, x[j][0].y); w.y = pk2(x[j][0].z, x[j][0].w); w.z = pk2(x[j][1].x, x[j][1].y); w.w = pk2(x[j][1].z, x[j][1].w);
                    __builtin_nontemporal_store(w, (v4u*)(XR + (size_t)m * D + 8 * lane + 512 * j)); }
            }
            if (hb) {
                float ss = 0.f;
#pragma unroll
                for (int j = 0; j < 4; ++j) { const f32x4 t = x[j][0], u = x[j][1]; ss += ((t.x * t.x + t.y * t.y) + (t.z * t.z + t.w * t.w)) + ((u.x * u.x + u.y * u.y) + (u.z * u.z + u.w * u.w)); }
                const float r = 1.0f / sqrtf(wave_sum(ss) * (1.0f / D) + EPS);
#pragma unroll
                for (int j = 0; j < 4; ++j) { const f32x4 h0 = x[j][0] * r * UNL(v2[j]) + UNL(v3[j]), h1 = x[j][1] * r * UNH(v2[j]) + UNH(v3[j]);
                    v4u w; w.x = pk2(h0.x, h0.y); w.y = pk2(h0.z, h0.w); w.z = pk2(h1.x, h1.y); w.w = pk2(h1.z, h1.w); *(v4u*)(hb + (size_t)m * D + 8 * lane + 512 * j) = w; }
            }
        }
#undef LOADROW
#undef UNL
#undef UNH
    }
    for (int it = F.G - 1 - F.bid; it < MS / 4; it += F.G) {
        LAS float* red = (LAS float*)(F.lds + RING_OFF);
        const int ms0 = it * 4, br = 4 + (ms0 >> 3), c = 4 * F.tid;
        f32x4 x[4], d[4];
#pragma unroll
        for (int i = 0; i < 4; ++i) { const size_t o = (size_t)(ms0 + i) * D + c;
            if (XIN_F32) x[i] = *(const f32x4*)(xin_s + o); else { const v2u q = *(const v2u*)(XR + (size_t)MP * D + o); x[i] = UNP(q); }
            if (HAS_DELTA) { f32x4 s = *(const f32x4*)(dpart + o);
#pragma unroll
                for (int q = 1; q < 4; ++q) s += *(const f32x4*)(dpart + (size_t)q * MS * D + o);
                d[i] = s; } }
        __syncthreads();
        if (HAS_DELTA) {
            const v2u g1 = *(const v2u*)(mgate + (size_t)br * NMOD + c);
#pragma unroll
            for (int i = 0; i < 4; ++i) { const float s = wave_sum((d[i].x * d[i].x + d[i].y * d[i].y) + (d[i].z * d[i].z + d[i].w * d[i].w)); if (lane == 0) red[i * 8 + F.wave] = s; }
            __syncthreads();
#pragma unroll
            for (int i = 0; i < 4; ++i) { const f32x4 a = *(const LAS f32x4*)(red + i * 8), b = *(const LAS f32x4*)(red + i * 8 + 4);
                const float r = 1.0f / sqrtf(((a.x + a.y) + (a.z + a.w) + (b.x + b.y) + (b.z + b.w)) * (1.0f / D) + EPS);
                x[i] = x[i] + UNP(g1) * (d[i] * r); }
        }
#pragma unroll
        for (int i = 0; i < 4; ++i) { const size_t o = (size_t)(ms0 + i) * D + c;
            if (out32_s) *(f32x4*)(out32_s + o) = x[i]; else { v2u w; w.x = pk2(x[i].x, x[i].y); w.y = pk2(x[i].z, x[i].w); *(v2u*)(XR + (size_t)MP * D + o) = w; } }
        if (hb) {
            const v2u g2 = *(const v2u*)(msc + (size_t)br * NMOD + c), g3 = *(const v2u*)(msh + (size_t)br * NMOD + c);
#pragma unroll
            for (int i = 0; i < 4; ++i) { const float s = wave_sum((x[i].x * x[i].x + x[i].y * x[i].y) + (x[i].z * x[i].z + x[i].w * x[i].w)); if (lane == 0) red[32 + i * 8 + F.wave] = s; }
            __syncthreads();
#pragma unroll
            for (int i = 0; i < 4; ++i) { const f32x4 a = *(const LAS f32x4*)(red + 32 + i * 8), b = *(const LAS f32x4*)(red + 32 + i * 8 + 4);
                const float r = 1.0f / sqrtf(((a.x + a.y) + (a.z + a.w) + (b.x + b.y) + (b.z + b.w)) * (1.0f / D) + EPS);
                const f32x4 h = x[i] * r * UNP(g2) + UNP(g3);
                __hip_atomic_store((unsigned long long*)(hb + (size_t)(MP + ms0 + i) * D + c), ((unsigned long long)pk2(h.z, h.w) << 32) | (unsigned long long)pk2(h.x, h.y), __ATOMIC_RELAXED, __HIP_MEMORY_SCOPE_AGENT); }
        }
        if (sig) asm volatile("s_waitcnt vmcnt(0)" ::: "memory");
        __syncthreads();
        if (sig && F.tid == 0) __hip_atomic_fetch_add(sig, 1u, __ATOMIC_RELAXED, __HIP_MEMORY_SCOPE_AGENT);
    }
}
#undef UNP
__device__ __forceinline__ void attn_sample_item(Frame& F, int l, int it, LAS float* pscr) {
    const int br = it % 3, mh = it / 3, ms = mh >> 4, h = mh & 15, b = ms >> 3, m = MP + ms, dsh = 2 * br, lane = F.lane;
    const bf16* Qb = (const bf16*)(F.ws + WS_Q); const bf16* Kb = (const bf16*)(F.ws + WS_K); const bf16* Vb = (const bf16*)(F.ws + WS_V);
    bf16* OB = (bf16*)(F.ws + WS_OB) + (size_t)br * MT * 1024; float* LSE = (float*)(F.ws + WS_LSE) + (size_t)br * MT * 16;
    const int tpos = WBUF + (ms & 7);
    const float slope2 = exp2f(-0.5f * (float)(h + 1)) * LOG2E;
    const float* ck = INP(I_CK) + ((size_t)(l * 8 + b) * WBUF) * 1024 + h * 64;
    const float* cv = INP(I_CV) + ((size_t)(l * 8 + b) * WBUF) * 1024 + h * 64;
    const bf16* kn = Kb + (size_t)(MP + b * 8) * 1024 + h * 64;
    const bf16* vn = Vb + (size_t)(MP + b * 8) * 1024 + h * 64;
    v4u qv[8];
#pragma unroll
    for (int c = 0; c < 8; ++c) qv[c] = *(const v4u*)(Qb + (size_t)m * 1024 + h * 64 + 8 * c);
    const int d0 = lane << dsh, d1 = (lane + 64) << dsh, i0 = tpos - d0, i1 = tpos - d1, i128 = tpos - (128 << dsh);
    const bool old0 = i0 < WBUF;
    const float* kr0 = ck + (size_t)(old0 ? i0 : WBUF - 1) * 1024; const float* kr1 = ck + (size_t)i1 * 1024; const bf16* kq0 = kn + (size_t)(old0 ? 0 : i0 - WBUF) * 1024;
    f32x4 ka[16], kb[16]; v4u kn8[8];
#pragma unroll
    for (int c = 0; c < 16; ++c) { ka[c] = *(const f32x4*)(kr0 + 4 * c); kb[c] = *(const f32x4*)(kr1 + 4 * c); }
#pragma unroll
    for (int c = 0; c < 8; ++c) kn8[c] = *(const v4u*)(kq0 + 8 * c);
    const float k128 = ck[(size_t)i128 * 1024 + lane]; const float q128 = bflo((unsigned)Qb[(size_t)m * 1024 + h * 64 + lane]);
    __builtin_amdgcn_sched_barrier(0);
    float a0 = 0.f, a1 = 0.f, an = 0.f;
#pragma unroll
    for (int c = 0; c < 8; ++c) { const v4u q = qv[c]; const f32x4 x0 = ka[2 * c], x1 = ka[2 * c + 1], y0 = kb[2 * c], y1 = kb[2 * c + 1]; const v4u k = kn8[c];
        a0 += bflo(q.x) * x0.x + bfhi(q.x) * x0.y + bflo(q.y) * x0.z + bfhi(q.y) * x0.w + bflo(q.z) * x1.x + bfhi(q.z) * x1.y + bflo(q.w) * x1.z + bfhi(q.w) * x1.w;
        a1 += bflo(q.x) * y0.x + bfhi(q.x) * y0.y + bflo(q.y) * y0.z + bfhi(q.y) * y0.w + bflo(q.z) * y1.x + bfhi(q.z) * y1.y + bflo(q.w) * y1.z + bfhi(q.w) * y1.w;
        an += bflo(q.x) * bflo(k.x) + bfhi(q.x) * bfhi(k.x) + bflo(q.y) * bflo(k.y) + bfhi(q.y) * bfhi(k.y) + bflo(q.z) * bflo(k.z) + bfhi(q.z) * bfhi(k.z) + bflo(q.w) * bflo(k.w) + bfhi(q.w) * bfhi(k.w); }
    const float s0 = (old0 ? a0 : an) - slope2 * (float)d0, s1 = a1 - slope2 * (float)d1;
    const float s128 = wave_sum(k128 * q128) - slope2 * (float)(128 << dsh);
    const float mx = fmaxf(wave_max(fmaxf(s0, s1)), s128);
    const float p0 = __builtin_amdgcn_exp2f(s0 - mx), p1 = __builtin_amdgcn_exp2f(s1 - mx), p128 = __builtin_amdgcn_exp2f(s128 - mx);
    const float sum = wave_sum(p0 + p1) + p128, inv = 1.0f / sum;
    pscr[lane] = p0 * inv; pscr[64 + lane] = p1 * inv; if (lane < 4) pscr[128 + lane] = lane == 0 ? p128 * inv : 0.f;
    LDS_WAIT(); asm volatile("" ::: "memory");
    const int ks = lane >> 4, dq = lane & 15;
    f32x4 vc[33]; v2u vw[2];
#pragma unroll
    for (int jt = 0; jt < 33; ++jt) { const int j = 4 * jt + ks; int idx = tpos - (j << dsh); idx = idx < 0 ? 0 : (idx >= WBUF ? WBUF - 1 : idx);
        vc[jt] = *(const f32x4*)(cv + (size_t)idx * 1024 + 4 * dq); }
#pragma unroll
    for (int jt = 0; jt < 2; ++jt) { const int j = 4 * jt + ks; const int idx = tpos - (j << dsh); vw[jt] = *(const v2u*)(vn + (size_t)(idx >= WBUF ? idx - WBUF : 0) * 1024 + 4 * dq); }
    __builtin_amdgcn_sched_barrier(0);
    f32x4 acc = (f32x4){0.f, 0.f, 0.f, 0.f};
#pragma unroll
    for (int jt = 0; jt < 33; ++jt) { const int j = 4 * jt + ks; const float p = pscr[j]; f32x4 v = vc[jt];
        if (jt < 2) { const int idx = tpos - (j << dsh); if (idx >= WBUF) v = (f32x4){bflo(vw[jt].x), bfhi(vw[jt].x), bflo(vw[jt].y), bfhi(vw[jt].y)}; }
        acc += v * p; }
#pragma unroll
    for (int e = 0; e < 4; ++e) { acc[e] += __shfl_xor(acc[e], 16); acc[e] += __shfl_xor(acc[e], 32); }
    if (lane < 16) { v2u w; w.x = pk2(acc.x, acc.y); w.y = pk2(acc.z, acc.w); *(v2u*)(OB + (size_t)m * 1024 + h * 64 + 4 * dq) = w; }
    if (lane == 0) LSE[(size_t)m * 16 + h] = mx + __builtin_amdgcn_logf(sum);
    LDS_WAIT(); asm volatile("" ::: "memory");
}
__device__ __forceinline__ void attn_sample_phase(Frame& F, int l) {
    LAS float* pscr = (LAS float*)(F.lds + RING_OFF + F.wave * 16384);
    const int gwr = (F.G - 1 - F.bid) * NWAVES + F.wave, NGW = F.G * NWAVES;
    for (int it = gwr; it < MS * NH * 3; it += NGW) attn_sample_item(F, l, it, pscr);
}
typedef const __attribute__((address_space(3))) char* lds_cptr;
typedef short v4i16_t __attribute__((ext_vector_type(4)));
typedef short s16x4 __attribute__((ext_vector_type(4)));
__device__ __forceinline__ s16x4 vtr(lds_cptr p) { return __builtin_bit_cast(s16x4, __builtin_amdgcn_ds_read_tr16_b64_v4i16((__attribute__((address_space(3))) v4i16_t*)p)); }
__device__ __forceinline__ unsigned cvtpk(float lo, float hi) { typedef float f2 __attribute__((ext_vector_type(2))); typedef __bf16 b2 __attribute__((ext_vector_type(2))); f2 v = {lo, hi}; b2 b = __builtin_convertvector(v, b2); return __builtin_bit_cast(unsigned, b); }
__device__ __forceinline__ void glds16(const void* gsrc, unsigned lds_dst) { unsigned keep;
    asm volatile("s_mov_b32 %0, m0\n\ts_mov_b32 m0, %2\n\ts_nop 0\n\tglobal_load_lds_dwordx4 %1, off\n\ts_mov_b32 m0, %0" : "=&s"(keep) : "v"(gsrc), "s"(lds_dst) : "memory"); }
struct AttnC { int br, dsh, r, qb, h; size_t rowb; };
__device__ __forceinline__ AttnC attn_coord(int w, int wave) {
    AttnC c; c.br = w >> 9; const int bh = (w & 511) >> 3, e = (w & 7) * 8 + wave, sh = 6 - 2 * c.br;
    c.dsh = 2 * c.br; c.r = e >> sh; c.qb = e & ((1 << sh) - 1); c.h = bh & 15; c.rowb = (size_t)(bh >> 4) * SEQ; return c;
}
__device__ __forceinline__ void attn_load_q(const Frame& F, const AttnC& c, int lane, bf16x8 (&qf)[4]) {
    const bf16* Qb = (const bf16*)(F.ws + WS_Q); const int r32 = lane & 31, hi = lane >> 5;
    const int tq = ((32 * c.qb + r32) << c.dsh) + c.r;
#pragma unroll
    for (int s = 0; s < 4; ++s) qf[s] = *(const bf16x8*)(Qb + (c.rowb + tq) * 1024 + c.h * 64 + 16 * s + 8 * hi);
}
template <int KB0, int KB1>
__device__ __forceinline__ void attn_load_k(const Frame& F, const AttnC& c, int lane, bf16x8 (&kf)[5][4]) {
    const bf16* Kb = (const bf16*)(F.ws + WS_K); const int r32 = lane & 31, hi = lane >> 5;
#pragma unroll
    for (int kb = KB0; kb < KB1; ++kb) {
        int ap = 32 * (c.qb - 4 + kb) + r32; ap = ap < 0 ? 0 : ap;
        const bf16* kr = Kb + (c.rowb + (size_t)((ap << c.dsh) + c.r)) * 1024 + c.h * 64 + 8 * hi;
#pragma unroll
        for (int s = 0; s < 4; ++s) kf[kb][s] = *(const bf16x8*)(kr + 16 * s);
    }
}
template <bool VISIBLE>
__device__ __forceinline__ void attn_v_dma(const Frame& F, const AttnC& c, int lane, LAS unsigned char* wl, int kb, int slot) {
    const bf16* Vb = (const bf16*)(F.ws + WS_V); const int vkey = (lane & 31) >> 2, vch = 4 * (lane >> 5) + (lane & 3);
#pragma unroll
    for (int i = 0; i < 4; ++i) { int ap = 32 * (c.qb - 4 + kb) + 8 * i + vkey; ap = ap < 0 ? 0 : ap;
        const bf16* src = Vb + (c.rowb + (size_t)((ap << c.dsh) + c.r)) * 1024 + c.h * 64 + vch * 8;
        if (VISIBLE) __builtin_amdgcn_global_load_lds((const unsigned*)src, (LAS unsigned*)(wl + slot * 4096 + i * 1024), 16, 0, 0);
        else glds16(src, (unsigned)__builtin_amdgcn_readfirstlane((unsigned)(uintptr_t)wl + slot * 4096 + i * 1024)); }
}
__device__ __forceinline__ AttnC attn_coord_i(int I) {
    AttnC c; c.br = I >> 12; const int rem = I & 4095, bh = rem >> 6, e = rem & 63, sh = 6 - 2 * c.br;
    c.dsh = 2 * c.br; c.r = e >> sh; c.qb = e & ((1 << sh) - 1); c.h = bh & 15; c.rowb = (size_t)(bh >> 4) * SEQ; return c;
}
__device__ __forceinline__ void attn_qk(const bf16x8 (&qf)[4], const bf16x8 (&kf)[5][4], float c1, f32x16 (&S)[5]) {
#pragma unroll
    for (int kb = 0; kb < 5; ++kb) {
        f32x16 acc;
#pragma unroll
        for (int i = 0; i < 16; ++i) acc[i] = c1;
#pragma unroll
        for (int s = 0; s < 4; ++s) acc = __builtin_amdgcn_mfma_f32_32x32x16_bf16(kf[kb][s], qf[s], acc, 0, 0, 0);
        S[kb] = acc;
    }
}
__device__ __forceinline__ float attn_sd(const AttnC& c) { return exp2f(-0.5f * (float)(c.h + 1)) * LOG2E * (float)(1 << c.dsh); }
#define ATTN_W(n) asm volatile("s_waitcnt vmcnt(" #n ")" ::: "memory")
__device__ __forceinline__ void attn_mfma_phase(Frame& F) {
    LAS unsigned char* wl = F.lds + RING_OFF + F.wave * 16384;
    const int lane = F.lane, r32 = lane & 31, hi = lane >> 5;
    constexpr int NITEM = 3 * 64 * 64;
    const int NW = F.G * NWAVES, per = (NITEM + NW - 1) / NW;
    int gwi = F.bid * NWAVES + F.wave; if (NW == 2048) gwi = (gwi * 683) & 2047;
    int I = gwi * per; asm volatile("" : "+s"(I));
    const int Iend = (I + per < NITEM) ? I + per : NITEM;
    if (I >= Iend) return;
    f32x16 S[5]; bf16x8 kf[5][4];
    { const AttnC c = attn_coord_i(I); bf16x8 qf[4];
      attn_load_q(F, c, lane, qf); attn_load_k<0, 5>(F, c, lane, kf);
#pragma unroll
      for (int kb = 0; kb < 4; ++kb) attn_v_dma<false>(F, c, lane, wl, kb, (c.qb - 4 + kb) & 3);
      attn_qk(qf, kf, attn_sd(c) * (float)(4 * hi - 128 - r32), S); }
    bool restart = true;
#pragma unroll 1
    for (;;) {
        const AttnC c = attn_coord_i(I);
        const bool has_next = I + 1 < Iend, same = has_next && (((I + 1) & ((64 >> c.dsh) - 1)) != 0);
        const int qb = c.qb;
        const float sd = attn_sd(c);
        bf16* OB = (bf16*)(F.ws + WS_OB) + (size_t)c.br * MT * 1024; float* LSE = (float*)(F.ws + WS_LSE) + (size_t)c.br * MT * 16;
        const int tq = ((32 * qb + r32) << c.dsh) + c.r;
        if (has_next) { int In = I + 1; asm volatile("" : "+s"(In)); const AttnC cn = attn_coord_i(In);
            if (same) {
#pragma unroll
                for (int kb = 0; kb < 4; ++kb)
#pragma unroll
                    for (int s = 0; s < 4; ++s) kf[kb][s] = kf[kb + 1][s];
                attn_load_k<4, 5>(F, cn, lane, kf);
            } else attn_load_k<0, 5>(F, cn, lane, kf);
        }
        __builtin_amdgcn_sched_barrier(0);
        float mx = -INFINITY;
#pragma unroll
        for (int kb = 0; kb < 5; ++kb) {
            const bool blk_ok = (qb - 4 + kb) >= 0;
#pragma unroll
            for (int i = 0; i < 16; ++i) { const int ikb = (i & 3) + 8 * (i >> 2), ik = ikb + 4 * hi;
                float s = S[kb][i] + sd * (float)(32 * kb + ikb);
                bool ok = blk_ok;
                if (kb == 0) ok = ok && (ik >= r32);
                if (kb == 4) ok = ok && (ik <= r32);
                s = ok ? s : -INFINITY; S[kb][i] = s; mx = fmaxf(mx, s); }
        }
        mx = fmaxf(mx, __shfl_xor(mx, 32));
        float l = 0.f;
        f32x16 O[2];
#pragma unroll
        for (int i = 0; i < 16; ++i) { O[0][i] = 0.f; O[1][i] = 0.f; }
        const lds_cptr vb = (lds_cptr)wl + (4 * hi + ((lane >> 2) & 3)) * 64 + ((lane >> 4) & 1) * 32 + (lane & 3) * 8;
        bf16x8 qn[4];
#pragma unroll
        for (int kb = 0; kb < 5; ++kb) {
            const int slot = (qb - 4 + kb) & 3;
            bf16x8 pf[2];
#pragma unroll
            for (int i = 0; i < 16; ++i) { const float p = __builtin_amdgcn_exp2f(S[kb][i] - mx); S[kb][i] = p; l += p; }
#pragma unroll
            for (int s = 0; s < 2; ++s) { v4u wv; wv.x = cvtpk(S[kb][8 * s + 0], S[kb][8 * s + 1]); wv.y = cvtpk(S[kb][8 * s + 2], S[kb][8 * s + 3]); wv.z = cvtpk(S[kb][8 * s + 4], S[kb][8 * s + 5]); wv.w = cvtpk(S[kb][8 * s + 6], S[kb][8 * s + 7]);
                pf[s] = __builtin_bit_cast(bf16x8, wv); }
            if (kb == 0 && restart) { if (!has_next) ATTN_W(0); else if (same) ATTN_W(4); else ATTN_W(20); }
            if (kb == 4) ATTN_W(0);
            const lds_cptr vs = vb + slot * 4096;
#pragma unroll
            for (int s = 0; s < 2; ++s)
#pragma unroll
                for (int dt = 0; dt < 2; ++dt) { const s16x4 lo = vtr(vs + s * 2048 + dt * 512), hh = vtr(vs + s * 2048 + dt * 512 + 1024);
                    const bf16x8 vf = (bf16x8){lo[0], lo[1], lo[2], lo[3], hh[0], hh[1], hh[2], hh[3]};
                    O[dt] = __builtin_amdgcn_mfma_f32_32x32x16_bf16(vf, pf[s], O[dt], 0, 0, 0); }
            if (kb == 0) { asm volatile("s_waitcnt lgkmcnt(0)" ::: "memory"); attn_v_dma<false>(F, c, lane, wl, 4, qb & 3);
                if (has_next) { int In = I + 1; asm volatile("" : "+s"(In)); attn_load_q(F, attn_coord_i(In), lane, qn); } }
        }
        l += __shfl_xor(l, 32);
        const float inv = 1.0f / l;
        bf16* orow = OB + (c.rowb + tq) * 1024 + c.h * 64 + 4 * hi;
#pragma unroll
        for (int dt = 0; dt < 2; ++dt)
#pragma unroll
            for (int g = 0; g < 4; ++g) { v2u wv; wv.x = cvtpk(O[dt][4 * g + 0] * inv, O[dt][4 * g + 1] * inv); wv.y = cvtpk(O[dt][4 * g + 2] * inv, O[dt][4 * g + 3] * inv);
                *(v2u*)(orow + 32 * dt + 8 * g) = wv; }
        if (hi == 0) LSE[(c.rowb + tq) * 16 + c.h] = mx + __builtin_amdgcn_logf(l);
        asm volatile("s_waitcnt lgkmcnt(0)" ::: "memory");
        if (!has_next) break;
        ++I; asm volatile("" : "+s"(I));
        { const AttnC cn = attn_coord_i(I);
          if (!same) {
#pragma unroll
              for (int kb = 0; kb < 4; ++kb) attn_v_dma<false>(F, cn, lane, wl, kb, (cn.qb - 4 + kb) & 3);
          }
          restart = !same;
          attn_qk(qn, kf, attn_sd(cn) * (float)(4 * hi - 128 - r32), S); }
    }
    asm volatile("s_waitcnt vmcnt(0) lgkmcnt(0)" ::: "memory");
}
#undef ATTN_W
template <int NTOK, bool SAMPLE>
__device__ __forceinline__ void conv_run(Frame& F, int l, int b, int t0, const f32x2 (&w)[CK], const f32x2 bias, int c) {
    const bf16* Ub = (const bf16*)(F.ws + WS_U); bf16* YP = (bf16*)(F.ws + WS_YPRE);
    unsigned ue[NTOK + 30];
#pragma unroll
    for (int j = 0; j < NTOK + 30; ++j) {
        if (SAMPLE) { if (j < 30) { const f32x2 v = *(const f32x2*)(INP(I_SC) + ((size_t)(l * 8 + b) * 30 + j) * CCH + c); ue[j] = pk2(v.x, v.y); }
                      else ue[j] = *(const unsigned*)(Ub + (size_t)(MP + b * 8 + j - 30) * 1024 + c); }
        else { const int t = t0 - 30 + j; ue[j] = t < 0 ? 0u : *(const unsigned*)(Ub + (size_t)(b * SEQ + t) * 1024 + c); }
    }
    if (SAMPLE) { float* co = F.out + O_CS + (size_t)(l * 8 + b) * 30 * CCH + c;
#pragma unroll
        for (int j = 0; j < 30; ++j) { f32x2 v; if (j + 8 < 30) v = *(const f32x2*)(INP(I_SC) + ((size_t)(l * 8 + b) * 30 + j + 8) * CCH + c); else v = (f32x2){bflo(ue[j + 8]), bfhi(ue[j + 8])}; *(f32x2*)(co + (size_t)j * CCH) = v; }
    } else if (t0 + NTOK == SEQ) { float* co = F.out + O_CP + (size_t)(l * 4 + b) * 30 * CCH + c;
#pragma unroll
        for (int j = 0; j < 30; ++j) { const unsigned v = ue[j + NTOK]; *(f32x2*)(co + (size_t)j * CCH) = (f32x2){bflo(v), bfhi(v)}; }
    }
    f32x2 uf[NTOK + 30];
#pragma unroll
    for (int j = 0; j < NTOK + 30; ++j) uf[j] = (f32x2){bflo(ue[j]), bfhi(ue[j])};
#pragma unroll
    for (int t = 0; t < NTOK; ++t) { f32x2 a = bias;
#pragma unroll
        for (int k = 0; k < CK; ++k) a += w[k] * uf[t + k];
        const size_t row = SAMPLE ? (size_t)(MP + b * 8 + t) : (size_t)(b * SEQ + t0 + t);
        *(unsigned*)(YP + row * 1024 + c) = pk2(a.x, a.y); }
}
__device__ __forceinline__ void conv_phase(Frame& F, int l) {
    const int c = F.wave * 128 + 2 * F.lane;
    f32x2 w[CK];
#pragma unroll
    for (int k = 0; k < CK; ++k) w[k] = *(const f32x2*)(INP(I_CW) + ((size_t)l * CK + k) * CCH + c);
    const f32x2 bias = *(const f32x2*)(INP(I_CB) + (size_t)l * CCH + c);
    for (int it = F.bid; it < 512 + 8; it += F.G) {
        if (it < 512) conv_run<16, false>(F, l, it >> 7, (it & 127) * 16, w, bias, c);
        else conv_run<8, true>(F, l, it - 512, 0, w, bias, c);
    }
}
__device__ __forceinline__ void onorm_phase(Frame& F, int l) {
    bf16* MIXIN = (bf16*)(F.ws + WS_MIXIN); const float* g = INP(I_GAO) + (size_t)l * AW;
    const bf16* OB = (const bf16*)(F.ws + WS_OB); const float* LSE = (const float*)(F.ws + WS_LSE); const bf16* YP = (const bf16*)(F.ws + WS_YPRE);
    const float* lng = INP(I_LNG) + (size_t)l * CCH; const float* lnb = INP(I_LNB) + (size_t)l * CCH;
    const int gw = F.bid * NWAVES + F.wave, NGW = F.G * NWAVES, lane = F.lane;
#define STOREV(it_) do { v4u w0, w1; \
        w0.x = pk2(v[0].x, v[0].y); w0.y = pk2(v[0].z, v[0].w); w0.z = pk2(v[1].x, v[1].y); w0.w = pk2(v[1].z, v[1].w); \
        w1.x = pk2(v[2].x, v[2].y); w1.y = pk2(v[2].z, v[2].w); w1.z = pk2(v[3].x, v[3].y); w1.w = pk2(v[3].z, v[3].w); \
        bf16* dst = MIXIN + (size_t)((it_) >> 1) * D + ((it_) & 1) * 1024 + 16 * lane; *(v4u*)dst = w0; *(v4u*)(dst + 8) = w1; } while (0)
    if ((gw & 1) == 0) {
        const int hd = lane >> 2;
        float ls[2][3]; v4u ob[2][6];
#define LOAD0(b, it_) do { const int m_ = (it_) >> 1; \
            ls[b][0] = LSE[(size_t)m_ * 16 + hd]; ls[b][1] = LSE[((size_t)MT + m_) * 16 + hd]; ls[b][2] = LSE[((size_t)2 * MT + m_) * 16 + hd]; \
            _Pragma("unroll") for (int q = 0; q < 3; ++q) { ob[b][2 * q] = *(const v4u*)(OB + ((size_t)q * MT + m_) * 1024 + 16 * lane); ob[b][2 * q + 1] = *(const v4u*)(OB + ((size_t)q * MT + m_) * 1024 + 16 * lane + 8); } } while (0)
#define MRG(A, B, C, k) (w0 * bflo(A[k]) + w1 * bflo(B[k]) + w2 * bflo(C[k])), (w0 * bfhi(A[k]) + w1 * bfhi(B[k]) + w2 * bfhi(C[k]))
#define COMP0(b, it_) do { f32x4 v[4]; \
            const float l0 = ls[b][0], l1 = ls[b][1], l2 = ls[b][2]; \
            const float mx = fmaxf(l0, fmaxf(l1, l2)); float w0 = __builtin_amdgcn_exp2f(l0 - mx), w1 = __builtin_amdgcn_exp2f(l1 - mx), w2 = __builtin_amdgcn_exp2f(l2 - mx); \
            const float inv = 1.0f / (w0 + w1 + w2); w0 *= inv; w1 *= inv; w2 *= inv; \
            const v4u a0 = ob[b][0], a1 = ob[b][1], b0 = ob[b][2], b1 = ob[b][3], c0 = ob[b][4], c1 = ob[b][5]; \
            v[0] = (f32x4){MRG(a0, b0, c0, 0), MRG(a0, b0, c0, 1)}; v[1] = (f32x4){MRG(a0, b0, c0, 2), MRG(a0, b0, c0, 3)}; \
            v[2] = (f32x4){MRG(a1, b1, c1, 0), MRG(a1, b1, c1, 1)}; v[3] = (f32x4){MRG(a1, b1, c1, 2), MRG(a1, b1, c1, 3)}; \
            float ss = 0.f; \
            _Pragma("unroll") for (int j = 0; j < 4; ++j) ss += (v[j].x * v[j].x + v[j].y * v[j].y) + (v[j].z * v[j].z + v[j].w * v[j].w); \
            const float r = 1.0f / sqrtf(wave_sum(ss) * (1.0f / AW) + EPS); \
            _Pragma("unroll") for (int j = 0; j < 4; ++j) v[j] = v[j] * r * *(const f32x4*)(g + 16 * lane + 4 * j); \
            STOREV(it_); } while (0)
        int it = gw;
        if (it < 2 * MT) LOAD0(0, it);
        if (it + NGW < 2 * MT) LOAD0(1, it + NGW);
        for (; it < 2 * MT; it += 2 * NGW) {
            __builtin_amdgcn_sched_barrier(0);
            COMP0(0, it);
            if (it + 2 * NGW < 2 * MT) LOAD0(0, it + 2 * NGW);
            __builtin_amdgcn_sched_barrier(0);
            if (it + NGW < 2 * MT) { COMP0(1, it + NGW); if (it + 3 * NGW < 2 * MT) LOAD0(1, it + 3 * NGW); }
        }
#undef LOAD0
#undef COMP0
#undef MRG
    } else {
        v4u yq[2][2];
#define LOAD1(b, it_) do { const int m_ = (it_) >> 1; yq[b][0] = *(const v4u*)(YP + (size_t)m_ * 1024 + 16 * lane); yq[b][1] = *(const v4u*)(YP + (size_t)m_ * 1024 + 16 * lane + 8); } while (0)
#define COMP1(b, it_) do { f32x4 v[4]; const v4u a0 = yq[b][0], a1 = yq[b][1]; \
            v[0] = (f32x4){bflo(a0.x), bfhi(a0.x), bflo(a0.y), bfhi(a0.y)}; v[1] = (f32x4){bflo(a0.z), bfhi(a0.z), bflo(a0.w), bfhi(a0.w)}; \
            v[2] = (f32x4){bflo(a1.x), bfhi(a1.x), bflo(a1.y), bfhi(a1.y)}; v[3] = (f32x4){bflo(a1.z), bfhi(a1.z), bflo(a1.w), bfhi(a1.w)}; \
            float s = 0.f; \
            _Pragma("unroll") for (int j = 0; j < 4; ++j) s += (v[j].x + v[j].y) + (v[j].z + v[j].w); \
            const float mean = wave_sum(s) * (1.0f / CCH); float q = 0.f; \
            _Pragma("unroll") for (int j = 0; j < 4; ++j) { v[j] = v[j] - mean; q += (v[j].x * v[j].x + v[j].y * v[j].y) + (v[j].z * v[j].z + v[j].w * v[j].w); } \
            const float rstd = 1.0f / sqrtf(wave_sum(q) * (1.0f / CCH) + EPS); \
            _Pragma("unroll") for (int j = 0; j < 4; ++j) { f32x4 y = v[j] * rstd * *(const f32x4*)(lng + 16 * lane + 4 * j) + *(const f32x4*)(lnb + 16 * lane + 4 * j); \
                y.x *= sigm(y.x); y.y *= sigm(y.y); y.z *= sigm(y.z); y.w *= sigm(y.w); v[j] = y; } \
            STOREV(it_); } while (0)
        int it = gw;
        if (it < 2 * MT) LOAD1(0, it);
        if (it + NGW < 2 * MT) LOAD1(1, it + NGW);
        for (; it < 2 * MT; it += 2 * NGW) {
            __builtin_amdgcn_sched_barrier(0);
            COMP1(0, it);
            if (it + 2 * NGW < 2 * MT) LOAD1(0, it + 2 * NGW);
            __builtin_amdgcn_sched_barrier(0);
            if (it + NGW < 2 * MT) { COMP1(1, it + NGW); if (it + 3 * NGW < 2 * MT) LOAD1(1, it + 3 * NGW); }
        }
#undef LOAD1
#undef COMP1
    }
#undef STOREV
}
template <int K>
__device__ __forceinline__ void skinny_phase(Frame& F, const bf16* A, const bf16* Bt, int N, float* part) {
    LAS float* red = (LAS float*)(F.lds + RING_OFF);
    constexpr int Kq = K / 4, Kw = Kq / 8, NS = Kw / 16;
    const int lane = launder(F.lane), r = lane & 31, h = lane >> 5, nsl = N / 32; const int tid = launder(F.tid);
    for (int it = F.bid; it < nsl * 4; it += F.G) {
        const int ns = it >> 2, kq = it & 3, k0 = kq * Kq + F.wave * Kw;
        f32x16 acc0, acc1;
#pragma unroll
        for (int i = 0; i < 16; ++i) { acc0[i] = 0.f; acc1[i] = 0.f; }
        const bf16* a0p = A + (size_t)r * K + k0 + 8 * h; const bf16* a1p = a0p + (size_t)32 * K; const bf16* bp = Bt + (size_t)(ns * 32 + r) * K + k0 + 8 * h;
        bf16x8 a0[NS], a1[NS], bv[NS];
#pragma unroll
        for (int s = 0; s < NS; ++s) { a0[s] = *(const bf16x8*)(a0p + 16 * s); a1[s] = *(const bf16x8*)(a1p + 16 * s); bv[s] = *(const bf16x8*)(bp + 16 * s); }
        __builtin_amdgcn_sched_barrier(0);
#pragma unroll
        for (int s = 0; s < NS; ++s) { acc0 = __builtin_amdgcn_mfma_f32_32x32x16_bf16(a0[s], bv[s], acc0, 0, 0, 0); acc1 = __builtin_amdgcn_mfma_f32_32x32x16_bf16(a1[s], bv[s], acc1, 0, 0, 0); }
        __syncthreads();
#pragma unroll
        for (int i = 0; i < 16; ++i) { const int row = (i & 3) + 8 * (i >> 2) + 4 * h; red[(F.wave * 64 + row) * 32 + r] = acc0[i]; red[(F.wave * 64 + 32 + row) * 32 + r] = acc1[i]; }
        __syncthreads();
        { const int o = tid * 4, row = o >> 5, col = o & 31; f32x4 s = (f32x4){0.f, 0.f, 0.f, 0.f};
#pragma unroll
          for (int wv = 0; wv < 8; ++wv) s += *(const LAS f32x4*)(red + (wv * 64 + row) * 32 + col);
          *(f32x4*)(part + ((size_t)kq * MS + row) * N + ns * 32 + col) = s; }
    }
    __syncthreads();
}

namespace pg8 {
struct GatedOrder : StaticOrder {
    const unsigned* ready;
    __device__ __forceinline__ void a_ready(const Unit& u) const {
        if (u.pm == 32) {
            if (threadIdx.x < 64) { unsigned sp = 0;
                while ((unsigned)__builtin_amdgcn_readfirstlane(__hip_atomic_load(ready, __ATOMIC_RELAXED, __HIP_MEMORY_SCOPE_AGENT)) < 16u) { __builtin_amdgcn_s_sleep(2); if (++sp > (1u << 24)) break; }
                __builtin_amdgcn_fence(__ATOMIC_ACQUIRE, "agent");
                asm volatile("s_waitcnt vmcnt(0)" ::: "memory"); }
            asm volatile("" ::: "memory"); __builtin_amdgcn_s_barrier(); asm volatile("" ::: "memory");
        }
    }
};
__device__ __forceinline__ f32x4 ubl(const u32x4 v) { return (f32x4){__builtin_bit_cast(float, v.x << 16), __builtin_bit_cast(float, v.x & 0xffff0000u), __builtin_bit_cast(float, v.y << 16), __builtin_bit_cast(float, v.y & 0xffff0000u)}; }
__device__ __forceinline__ f32x4 ubh(const u32x4 v) { return (f32x4){__builtin_bit_cast(float, v.z << 16), __builtin_bit_cast(float, v.z & 0xffff0000u), __builtin_bit_cast(float, v.w << 16), __builtin_bit_cast(float, v.w & 0xffff0000u)}; }
__device__ __forceinline__ void row_stats_a(const f32x4 (&v)[2][2][4][2], const Unit& u, int wr, int wc, int fr, int fq, PG8_LAS unsigned char* lds, int wid, int lane, unsigned* xs, unsigned* cnt) {
    PG8_LAS float* P = (PG8_LAS float*)lds;
    PG8_LAS float* S = (PG8_LAS float*)(lds + 4096);
#pragma unroll
    for (int ai = 0; ai < 2; ++ai)
#pragma unroll
        for (int m = 0; m < 4; ++m) { float s = 0.f;
#pragma unroll
            for (int bj = 0; bj < 2; ++bj)
#pragma unroll
                for (int n = 0; n < 2; ++n) { const f32x4 x = v[ai][bj][m][n]; s += (x[0] * x[0] + x[1] * x[1]) + (x[2] * x[2] + x[3] * x[3]); }
            s += __shfl_xor(s, 16); s += __shfl_xor(s, 32);
            if (fq == 0) P[(ai * HALF + wr * 64 + m * 16 + fr) * 4 + wc] = s; }
    asm volatile("s_waitcnt lgkmcnt(0)" ::: "memory"); __builtin_amdgcn_s_barrier(); asm volatile("" ::: "memory");
    const int row = wid * 32 + (lane & 31);
    if (lane < 32) { const f32x4 p = *(const PG8_LAS f32x4*)(P + row * 4);
        __hip_atomic_store(xs + (size_t)(u.pm * BM + row) * 8 + u.pn, __builtin_bit_cast(unsigned, (p[0] + p[1]) + (p[2] + p[3])), __ATOMIC_RELAXED, __HIP_MEMORY_SCOPE_AGENT); }
    asm volatile("s_waitcnt vmcnt(0)" ::: "memory");
    if (lane == 0) __hip_atomic_fetch_add(cnt + 64 * u.pm, 1u, __ATOMIC_RELAXED, __HIP_MEMORY_SCOPE_AGENT);
    if (wid == 0) { unsigned sp = 0;
        while ((unsigned)__builtin_amdgcn_readfirstlane(__hip_atomic_load(cnt + 64 * u.pm, __ATOMIC_RELAXED, __HIP_MEMORY_SCOPE_AGENT)) < 64u) { __builtin_amdgcn_s_sleep(2); if (++sp > (1u << 24)) break; }
        __builtin_amdgcn_fence(__ATOMIC_ACQUIRE, "agent"); }
    asm volatile("s_waitcnt vmcnt(0) lgkmcnt(0)" ::: "memory"); __builtin_amdgcn_s_barrier(); asm volatile("" ::: "memory");
}
__device__ __forceinline__ void row_stats_b(const Unit& u, PG8_LAS unsigned char* lds, int wid, int lane, unsigned* xs) {
    PG8_LAS float* S = (PG8_LAS float*)(lds + 4096);
    const int row = wid * 32 + (lane & 31);
    if (lane < 32) { const unsigned* slot = xs + (size_t)(u.pm * BM + row) * 8; float q = 0.f;
#pragma unroll
        for (int t = 0; t < 8; ++t) q += __builtin_bit_cast(float, __hip_atomic_load(slot + t, __ATOMIC_RELAXED, __HIP_MEMORY_SCOPE_AGENT));
        S[row] = 1.0f / sqrtf(q * (1.0f / 2048.0f) + 1e-6f); }
    asm volatile("s_waitcnt lgkmcnt(0)" ::: "memory"); __builtin_amdgcn_s_barrier(); asm volatile("" ::: "memory");
}
struct EpiResNorm {
    static constexpr bool PERM = true, AFTER_DRAIN = true;
    unsigned char* ws; float* out32;
    unsigned og, oa, ob, ocnt;
    __device__ __forceinline__ void fused(f32x4 (&acc)[2][2][4][2], const Unit& u, int wr, int wc, int fr, int fq, PG8_LAS unsigned char* lds, int wid, int lane) const {
        const PG8_LAS float* S = (const PG8_LAS float*)(lds + 4096);
        bf16_t* XR = (bf16_t*)(ws + WS_XRES); const bf16_t* MODT = (const bf16_t*)(ws + WS_MOD);
        unsigned* xs = (unsigned*)(ws + WS_O32); unsigned* cnt = (unsigned*)(ws + WS_CTL) + ocnt;
        const int c0 = u.pn * BM + wc * 32 + 8 * fq; const size_t vo = (size_t)(u.pm >> 3) * NMOD + c0;
        u32x4 g1[2];
#pragma unroll
        for (int bj = 0; bj < 2; ++bj) g1[bj] = *(const u32x4*)(MODT + og + vo + bj * HALF);
        u32x4 pre[4][2];
#pragma unroll
        for (int m = 0; m < 4; ++m)
#pragma unroll
            for (int bj = 0; bj < 2; ++bj) pre[m][bj] = *(const u32x4*)(XR + (size_t)(u.pm * BM + wr * 64 + m * 16 + fr) * D + c0 + bj * HALF);
        row_stats_a(acc, u, wr, wc, fr, fq, lds, wid, lane, xs, cnt);
        u32x4 pre1[4][2];
#pragma unroll
        for (int m = 0; m < 4; ++m)
#pragma unroll
            for (int bj = 0; bj < 2; ++bj) pre1[m][bj] = *(const u32x4*)(XR + (size_t)(u.pm * BM + HALF + wr * 64 + m * 16 + fr) * D + c0 + bj * HALF);
        row_stats_b(u, lds, wid, lane, xs);
#pragma unroll
        for (int ai = 0; ai < 2; ++ai)
#pragma unroll
            for (int m = 0; m < 4; ++m) { const int r = ai * HALF + wr * 64 + m * 16 + fr; const float rs = S[r];
#pragma unroll
                for (int bj = 0; bj < 2; ++bj) { const u32x4 xq = ai == 0 ? pre[m][bj] : pre1[m][bj];
                    acc[ai][bj][m][0] = ubl(xq) + ubl(g1[bj]) * (acc[ai][bj][m][0] * rs); acc[ai][bj][m][1] = ubh(xq) + ubh(g1[bj]) * (acc[ai][bj][m][1] * rs); }
                asm volatile("" : "+v"(acc[ai][0][m][0]), "+v"(acc[ai][0][m][1]), "+v"(acc[ai][1][m][0]), "+v"(acc[ai][1][m][1])); }
        if (out32) {
#pragma unroll
            for (int ai = 0; ai < 2; ++ai)
#pragma unroll
                for (int m = 0; m < 4; ++m) { float* o = out32 + (size_t)(u.pm * BM + ai * HALF + wr * 64 + m * 16 + fr) * D + c0;
#pragma unroll
                    for (int bj = 0; bj < 2; ++bj) { *(f32x4*)(o + bj * HALF) = acc[ai][bj][m][0]; *(f32x4*)(o + bj * HALF + 4) = acc[ai][bj][m][1]; } }
        } else {
            bf16_t* Hh = (bf16_t*)(ws + WS_H);
            u32x4 g2[2], g3[2];
#pragma unroll
            for (int bj = 0; bj < 2; ++bj) { g2[bj] = *(const u32x4*)(MODT + oa + vo + bj * HALF); g3[bj] = *(const u32x4*)(MODT + ob + vo + bj * HALF); }
            row_stats_a(acc, u, wr, wc, fr, fq, lds, wid, lane, xs + 8192 * 8, cnt + 2048); row_stats_b(u, lds, wid, lane, xs + 8192 * 8);
#pragma unroll
            for (int ai = 0; ai < 2; ++ai)
#pragma unroll
                for (int m = 0; m < 4; ++m) { const int r = ai * HALF + wr * 64 + m * 16 + fr; const float rs = S[r]; const size_t off = (size_t)(u.pm * BM + r) * D + c0;
#pragma unroll
                    for (int bj = 0; bj < 2; ++bj) { const f32x4 x0 = acc[ai][bj][m][0], x1 = acc[ai][bj][m][1];
                        *(u32x4*)(XR + off + bj * HALF) = pack8(x0, x1);
                        *(u32x4*)(Hh + off + bj * HALF) = pack8(x0 * rs * ubl(g2[bj]) + ubl(g3[bj]), x1 * rs * ubh(g2[bj]) + ubh(g3[bj])); } }
        }
    }
};
}

#ifndef N_LAUNCH_MODE
#define N_LAUNCH_MODE 1
#endif
struct Args { const float* in[N_IN]; float* out; unsigned char* ws; int ph_lo, ph_hi; };
constexpr int PH_PRO = 3, PH_PER_LAYER = 8, PH_TOTAL = PH_PRO + DEPTH * PH_PER_LAYER;
__global__ void __launch_bounds__(NWAVES * 64, 2) fwd(Args args) {
    extern __shared__ __attribute__((aligned(16))) unsigned char lds[];
    Frame F;
    F.lds = (LAS unsigned char*)lds;
    F.MISC = (volatile LAS unsigned*)(F.lds + MISC_OFF);
    F.tid = threadIdx.x; F.lane = F.tid & 63; F.wave = __builtin_amdgcn_readfirstlane(F.tid >> 6);
    F.G = gridDim.x; F.bid = blockIdx.x;
    F.ws = args.ws; F.out = args.out; F.ctl = (gu32*)(args.ws + WS_CTL);
    for (int u = F.tid; u < (LDS_BYTES - LDSCTL_OFF) / 4; u += NWAVES * 64) ((LAS unsigned*)(F.lds + LDSCTL_OFF))[u] = 0u;
    __syncthreads();
    if (F.tid == 0) {
#pragma unroll
        for (int i = 0; i < N_IN; ++i) ((LAS unsigned long long*)(F.lds + LDSCTL_OFF))[i] = (unsigned long long)args.in[i];
    }
    __syncthreads();
#if N_LAUNCH_MODE == 1
    constexpr int lo = 0, hi = PH_TOTAL; constexpr bool multi = true;
#else
    const int lo = args.ph_lo, hi = args.ph_hi;
    const bool multi = (hi - lo) > 1;
#endif
    XcdBarrier bar; bar.bar = (unsigned*)(F.ctl + CW_BAR); bar.x = 0; bar.st = nullptr;
    if (multi) bar = xcd_barrier_post((unsigned*)(F.ctl + CW_BAR), F.MISC + 8);
#define RELAUNDER() do { F.lane = lane_id_now(); F.tid = F.wave * 64 + F.lane; { unsigned long long w_ = (unsigned long long)F.ws, o_ = (unsigned long long)F.out; asm volatile("" : "+s"(w_), "+s"(o_)); F.ws = (unsigned char*)(GAS unsigned char*)w_; F.out = (float*)(GAS float*)o_; } } while (0)
#define RELAUNDER_V() (F.wave * 64 + lane_id_now())
#define IN(k) (lo <= (k) && (k) < hi)
#define SEAM(k) do { if (IN(k) && IN((k) + 1)) { xcd_barrier(bar); if (PROBE_DUP == 200) xcd_barrier(bar); } } while (0)

#define Hb ((bf16*)(F.ws + WS_H))
#define SIGW(k) ((unsigned*)(F.ws + WS_CTL) + 131072 + 64 * (k))
#define MIXIN ((bf16*)(F.ws + WS_MIXIN))
#define MIX ((bf16*)(F.ws + WS_MIX))
#define FACT ((bf16*)(F.ws + WS_FACT))
#define Fb ((bf16*)(F.ws + WS_F))
#define SKP ((float*)(F.ws + WS_SKP))
#define MOD ((const bf16*)(F.ws + WS_MOD))

#ifndef PHMASK
#define PHMASK 0xFFFF
#endif
#define PM(k) ((PHMASK >> (k)) & 1)
#ifndef PROBE_DUP
#define PROBE_DUP (-1)
#endif
#define REP(k) for (int rep_ = 0; rep_ < ((PROBE_DUP == (k)) ? 2 : 1); ++rep_)
    if (PM(0) && IN(0)) { REP(0) { REP(100) { RELAUNDER(); p0_transposes(F); } REP(101) { RELAUNDER(); p0_mod_partials(F); } REP(102) { RELAUNDER(); if (F.G != 256) p0_cache_copy(F); } } } SEAM(0);
    if (PM(1) && IN(1)) { RELAUNDER(); p0_mod_reduce(F); } SEAM(1);
    if (PM(2) && IN(2)) {
        RELAUNDER();
        resnorm_rows<false, true>(F, INP(I_XP), INP(I_XS), nullptr, nullptr, nullptr, nullptr, nullptr, MOD + 1 * D, MOD + 0 * D, Hb, SIGW(8));
    } SEAM(2);

    for (int l = 0; l < DEPTH; ++l) {
        const int pb = PH_PRO + l * PH_PER_LAYER;
#define modl (MOD + (size_t)l * 12 * NMOD)
        if (PM(3) && IN(pb + 0)) REP(3) {
            pg8::Gemm g{Hb, (const bf16*)(F.ws + WS_WIN + l * SZ_WIN), MPAD, NIN, D}; pg8::GatedOrder S; S.init(MPAD, NIN, F.G, F.bid); S.ready = SIGW(l == 0 ? 8 : (l - 1) * 2 + 1);
            pg8::EpiIn E{(bf16*)(F.ws + WS_Q), (size_t)(WS_K - WS_Q) / 2, (bf16*)(F.ws + WS_U),
                         F.out + O_KP + (size_t)l * MP * 1024, (size_t)(O_VP - O_KP), F.out + O_KS + (size_t)l * 8 * WBUF * 1024, (size_t)(O_VS - O_KS), QSCALE};
            pg8::gemm_phase<pg8::EpiIn, pg8::GatedOrder, true, true>(F.lds + RING_OFF, g, S, E, (RELAUNDER_V()));
            if (F.G == 256 && F.bid >= 148) { RELAUNDER(); tail_copy(F, l, F.bid - 148); }
        } SEAM(pb + 0);
        if (PM(4) && IN(pb + 1)) REP(4) {
#ifndef NO_ATTN
            RELAUNDER();
            REP(40) { RELAUNDER(); attn_mfma_phase(F); }
            RELAUNDER();
            REP(41) attn_sample_phase(F, l);
#endif
#ifndef NO_CONV
            RELAUNDER();
            REP(42) conv_phase(F, l);
#endif
        } SEAM(pb + 1);
        if (PM(5) && IN(pb + 2)) REP(5) { RELAUNDER(); onorm_phase(F, l); } SEAM(pb + 2);
        if (PM(6) && IN(pb + 3)) REP(6) {
            pg8::Gemm g{MIXIN, (const bf16*)(F.ws + WS_WOUT + l * SZ_WOUT), MP, D, D}; pg8::StaticOrder S; S.init(MP, D, F.G, F.bid);
            pg8::EpiResNorm E{F.ws, nullptr, (unsigned)(l * 12 * NMOD + 2 * D), (unsigned)(l * 12 * NMOD + 4 * D), (unsigned)(l * 12 * NMOD + 3 * D), (unsigned)(65536 + (l * 2 + 0) * 4096)};
            pg8::gemm_phase<pg8::EpiResNorm, pg8::StaticOrder, true, true>(F.lds + RING_OFF, g, S, E, (RELAUNDER_V()));
#ifndef NO_SKINNY
            RELAUNDER();
            skinny_phase<D>(F, MIXIN + (size_t)MP * D, (const bf16*)(F.ws + WS_WOUT + l * SZ_WOUT), D, SKP);
#endif
        } SEAM(pb + 3);
        if (PM(7) && IN(pb + 4)) {
            RELAUNDER();
            resnorm_rows<true, false, false>(F, nullptr, nullptr, nullptr, nullptr, MIX, SKP, modl + 2 * D, modl + 4 * D, modl + 3 * D, Hb, SIGW(l * 2 + 0));
        }
        if (PM(8) && IN(pb + 5)) REP(8) {
            pg8::Gemm g{Hb, (const bf16*)(F.ws + WS_WGU + l * SZ_WGU), MPAD, NGU, D}; pg8::GatedOrder S; S.init(MPAD, NGU, F.G, F.bid); S.ready = SIGW(l * 2 + 0);
            pg8::EpiSwiGLU E{FACT, DFF};
            pg8::gemm_phase<pg8::EpiSwiGLU, pg8::GatedOrder, true, true>(F.lds + RING_OFF, g, S, E, (RELAUNDER_V()));
            if (F.G == 256 && F.bid >= 172) { RELAUNDER(); tail_copy(F, l, 108 + F.bid - 172); }
        } SEAM(pb + 5);
        if (PM(9) && IN(pb + 6)) REP(9) {
            pg8::Gemm g{FACT, (const bf16*)(F.ws + WS_WDN + l * SZ_WDN), MP, D, DFF}; pg8::StaticOrder S; S.init(MP, D, F.G, F.bid);
            const int ln = (l == DEPTH - 1) ? l : l + 1;
            pg8::EpiResNorm E{F.ws, (l == DEPTH - 1) ? F.out + O_YP : nullptr, (unsigned)(l * 12 * NMOD + 5 * D), (unsigned)(ln * 12 * NMOD + 1 * D), (unsigned)(ln * 12 * NMOD + 0 * D), (unsigned)(65536 + (l * 2 + 1) * 4096)};
            pg8::gemm_phase<pg8::EpiResNorm, pg8::StaticOrder, true, true>(F.lds + RING_OFF, g, S, E, (RELAUNDER_V()));
#ifndef NO_SKINNY
            RELAUNDER();
            skinny_phase<DFF>(F, FACT + (size_t)MP * DFF, (const bf16*)(F.ws + WS_WDN + l * SZ_WDN), D, SKP);
#endif
        } SEAM(pb + 6);
        if (PM(10) && IN(pb + 7)) {
            const bool last = (l == DEPTH - 1);
            float* op = last ? F.out + O_YP : nullptr; float* os = last ? F.out + O_YS : nullptr;
            const bf16* modn = MOD + (size_t)(last ? l : l + 1) * 12 * NMOD;
            RELAUNDER();
            resnorm_rows<true, false, false>(F, nullptr, nullptr, op, os, Fb, SKP, modl + 5 * D, modn + 1 * D, modn + 0 * D, last ? nullptr : Hb, SIGW(l * 2 + 1));
        }
    }
#undef IN
#undef SEAM
#undef Hb
#undef MIXIN
#undef MIX
#undef FACT
#undef Fb
#undef SKP
#undef MOD
#undef modl
}

extern "C" void kernel_launch(void* const* d_in, const int* in_sizes, int n_in, void* d_out, int out_size, void* d_ws, size_t ws_size, hipStream_t stream) {
    static int grid = 0;
    if (grid == 0) {
        if (n_in != N_IN || (size_t)out_size != O_END || ws_size < WS_END) { fprintf(stderr, "kernel_launch: unexpected shapes: n_in %d out %d ws %zu (need %zu)\n", n_in, out_size, ws_size, (size_t)WS_END); grid = -1; return; }
        int dev = 0, cus = 0, per_cu = 0;
        if (hipGetDevice(&dev) != hipSuccess || hipDeviceGetAttribute(&cus, hipDeviceAttributeMultiprocessorCount, dev) != hipSuccess) { grid = -1; return; }
        if (hipFuncSetAttribute((const void*)fwd, hipFuncAttributeMaxDynamicSharedMemorySize, LDS_BYTES) != hipSuccess) { fprintf(stderr, "kernel_launch: hipFuncSetAttribute failed\n"); grid = -1; return; }
        if (hipOccupancyMaxActiveBlocksPerMultiprocessor(&per_cu, (const void*)fwd, NWAVES * 64, LDS_BYTES) != hipSuccess || per_cu < 1) fprintf(stderr, "kernel_launch: occupancy query says %d\n", per_cu);
        (void)hipGetLastError();
        if (cus != 256) { fprintf(stderr, "kernel_launch: built for 256 CUs (one 256x256 unit per workgroup in the fused-norm GEMM phases), device has %d\n", cus); grid = -1; return; }
        grid = cus;
    }
    if (grid < 0) return;
    if (hipMemsetAsync((char*)d_ws + WS_CTL, 0, CTL_ZERO_BYTES, stream) != hipSuccess) return;
    Args a{};
    for (int i = 0; i < N_IN; ++i) a.in[i] = (const float*)d_in[i];
    a.out = (float*)d_out; a.ws = (unsigned char*)d_ws;
    if (N_LAUNCH_MODE == 1) { a.ph_lo = 0; a.ph_hi = PH_TOTAL; hipLaunchKernelGGL(fwd, dim3(grid), dim3(NWAVES * 64), LDS_BYTES, stream, a); }
    else for (int p = 0; p < PH_TOTAL; ++p) { a.ph_lo = p; a.ph_hi = p + 1; hipLaunchKernelGGL(fwd, dim3(grid), dim3(NWAVES * 64), LDS_BYTES, stream, a); }
}
```

```cpp
#define PROBE_DUP -1
#include <hip/hip_runtime.h>
#include <cstdio>
#include <cstdint>
#include <cmath>
namespace pg8 {
#define PG8_LAS __attribute__((address_space(3)))
typedef unsigned short bf16_t;
typedef short bf16x8 __attribute__((ext_vector_type(8)));
typedef float f32x4 __attribute__((ext_vector_type(4)));
typedef unsigned u32x4 __attribute__((ext_vector_type(4)));
constexpr int BM = 256, BK = 64, HALF = 128, HTB = HALF * BK * 2  , STAGE_BYTES = 8 * HTB, NXCD = 8, WGM = 8;

__host__ __device__ __forceinline__ int lds_byte(int r, int c) { const int st = (r >> 4) * 2 + (c >> 5), rr = r & 15, cc = c & 31, ob = rr * 64 + cc * 2; return st * 1024 + (ob ^ (((ob >> 9) & 1) << 5)); }
__host__ __device__ __forceinline__ void stage_rc(int b, int& R, int& C) { const int st = b / 1024, sb = b % 1024, swz = sb ^ (((sb >> 9) & 1) << 5); R = (st >> 1) * 16 + swz / 64; C = (st & 1) * 32 + (swz % 64) / 2; }
__host__ __device__ __forceinline__ int perm32(int rho) { const int n = rho >> 4, i = rho & 15; return 8 * (i >> 2) + 4 * n + (i & 3); }

struct Unit { int pm, pn; };
struct Gemm { const bf16_t* A; const bf16_t* Bt; int M, N, K; };

struct StaticOrder {
    int nM, nN, nwg, G, c;
    __host__ __device__ void init(int M, int N, int G_, int c_) { nM = M / BM; nN = N / BM; nwg = nM * nN; G = G_; c = c_; }
    __host__ __device__ bool next(int i, Unit& u) const {
        const long L = (long)i * G + c; if (L >= nwg) return false;
        int wgid = (int)L; { const int q = nwg / NXCD, r = nwg % NXCD, xcd = wgid % NXCD, off = wgid / NXCD; wgid = (xcd < r ? xcd * (q + 1) : r * (q + 1) + (xcd - r) * q) + off; }
        const int nig = WGM * nN, gid = wgid / nig, fm = gid * WGM, gsz = (nM - fm) < WGM ? (nM - fm) : WGM;
        u.pm = fm + ((wgid % nig) % gsz); u.pn = (wgid % nig) / gsz; return true;
    }
    __device__ __forceinline__ void a_ready(const Unit&) const {}
    __device__ __forceinline__ void done(const Unit&) const {}
};

__device__ __forceinline__ unsigned cvt_pk_bf16(float lo, float hi) { unsigned r; asm volatile("v_cvt_pk_bf16_f32 %0, %1, %2" : "=v"(r) : "v"(lo), "v"(hi)); return r; }
constexpr int ROWS_P = 8192, ROWS_T = 8256;
__device__ __forceinline__ float sigmoidf_fast(float x) { return __builtin_amdgcn_rcpf(1.0f + __builtin_amdgcn_exp2f(-1.4426950408889634f * x)); }
__device__ __forceinline__ u32x4 pack8(const f32x4 v0, const f32x4 v1) { u32x4 w; w.x = cvt_pk_bf16(v0[0], v0[1]); w.y = cvt_pk_bf16(v0[2], v0[3]); w.z = cvt_pk_bf16(v1[0], v1[1]); w.w = cvt_pk_bf16(v1[2], v1[3]); return w; }

struct EpiIn {
    static constexpr bool PERM = true, AFTER_DRAIN = false;
    bf16_t *QKV; size_t qkv_stride;
    bf16_t *Ub; float *kvp; size_t kvp_stride;
    float *kvs; size_t kvs_stride; float qscale;
    __device__ __forceinline__ void operator()(const f32x4 (&acc)[2][2][4][2], const Unit& u, int wr, int wc, int fr, int fq) const {
        const int rbase = u.pm * BM + wr * 64 + fr;
        if (u.pn < 12) {
            const int t = u.pn >> 2, colt = (u.pn & 3) * 256 + wc * 32 + 8 * fq;
            bf16_t* dst = QKV + (size_t)t * qkv_stride; const float sc = t == 0 ? qscale : 1.f;
            float* fo_p = kvp + (size_t)(t == 2 ? 1 : 0) * kvp_stride; float* fo_s = kvs + (size_t)(t == 2 ? 1 : 0) * kvs_stride;
#pragma unroll
            for (int ai = 0; ai < 2; ++ai)
#pragma unroll
                for (int m = 0; m < 4; ++m) { const int row = rbase + ai * HALF + m * 16;
                    if (row < ROWS_T) {
                        float* fo = row < ROWS_P ? fo_p + (size_t)row * 1024 : fo_s + ((size_t)((row - ROWS_P) >> 3) * 2048 + 2040 + ((row - ROWS_P) & 7)) * 1024;
#pragma unroll
                        for (int bj = 0; bj < 2; ++bj) { const f32x4 v0 = acc[ai][bj][m][0] * sc, v1 = acc[ai][bj][m][1] * sc; const int col = colt + bj * HALF;
                            *(u32x4*)(dst + (size_t)row * 1024 + col) = pack8(v0, v1);
                            if (t != 0) { *(f32x4*)(fo + col) = v0; *(f32x4*)(fo + col + 4) = v1; } } } }
        } else {
            const int ch = (u.pn - 12) * 128 + wc * 32 + 8 * fq;
#pragma unroll
            for (int ai = 0; ai < 2; ++ai)
#pragma unroll
                for (int m = 0; m < 4; ++m) { const int row = rbase + ai * HALF + m * 16;
                    if (row < ROWS_T) { f32x4 o[2];
#pragma unroll
                        for (int n = 0; n < 2; ++n) { const f32x4 a = acc[ai][0][m][n], g = acc[ai][1][m][n];
#pragma unroll
                            for (int e = 0; e < 4; ++e) o[n][e] = a[e] * sigmoidf_fast(g[e]); }
                        *(u32x4*)(Ub + (size_t)row * 1024 + ch) = pack8(o[0], o[1]); } }
        }
    }
};
struct EpiPlain {
    static constexpr bool PERM = true, AFTER_DRAIN = false;
    bf16_t* O; int ldc;
    __device__ __forceinline__ void operator()(const f32x4 (&acc)[2][2][4][2], const Unit& u, int wr, int wc, int fr, int fq) const {
        const int rbase = u.pm * BM + wr * 64 + fr, col0 = u.pn * BM + wc * 32 + 8 * fq;
#pragma unroll
        for (int ai = 0; ai < 2; ++ai)
#pragma unroll
            for (int m = 0; m < 4; ++m) { const int row = rbase + ai * HALF + m * 16;
                if (row < ROWS_T) {
#pragma unroll
                    for (int bj = 0; bj < 2; ++bj) *(u32x4*)(O + (size_t)row * ldc + col0 + bj * HALF) = pack8(acc[ai][bj][m][0], acc[ai][bj][m][1]); } }
    }
};
struct EpiSwiGLU {
    static constexpr bool PERM = true, AFTER_DRAIN = false;
    bf16_t* O; int ldc;
    __device__ __forceinline__ void operator()(const f32x4 (&acc)[2][2][4][2], const Unit& u, int wr, int wc, int fr, int fq) const {
        const int rbase = u.pm * BM + wr * 64 + fr, col0 = u.pn * 128 + wc * 32 + 8 * fq;
#if defined(PROBE_DUP) && PROBE_DUP == 80
        for (int rep_ = 0; rep_ < 2; ++rep_) { asm volatile("" ::: "memory");
#endif
#pragma unroll
        for (int ai = 0; ai < 2; ++ai)
#pragma unroll
            for (int m = 0; m < 4; ++m) { const int row = rbase + ai * HALF + m * 16;
                if (row < ROWS_T) { f32x4 o[2];
#pragma unroll
                    for (int n = 0; n < 2; ++n) { const f32x4 g = acc[ai][0][m][n], up = acc[ai][1][m][n];
#pragma unroll
                        for (int e = 0; e < 4; ++e) o[n][e] = g[e] * sigmoidf_fast(g[e]) * up[e]; }
                    *(u32x4*)(O + (size_t)row * ldc + col0) = pack8(o[0], o[1]); } }
#if defined(PROBE_DUP) && PROBE_DUP == 80
        }
#endif
    }
};
template <class Epi, class Sched, bool ALIGN_EPI = false, bool SP2 = false>
__device__ __forceinline__ void gemm_phase(PG8_LAS unsigned char* lds, const Gemm g, const Sched& S, const Epi& E, int tid_in) {
    int tid_ = tid_in; asm volatile("" : "+v"(tid_));
    const int tid = tid_, wid = __builtin_amdgcn_readfirstlane(tid >> 6), lane = tid & 63, wr = wid >> 2, wc = wid & 3, fr = lane & 15, fq = lane >> 4;
    const int K = g.K, nt = K / BK;
    unsigned voffA[2], voffB[2];
#pragma unroll
    for (int i = 0; i < 2; ++i) { int R, C; stage_rc(tid * 16 + i * 8192, R, C); const int Rb = Epi::PERM ? ((R & ~31) + perm32(R & 31)) : R;
        voffA[i] = (unsigned)(R * K + C) * 2u; voffB[i] = (unsigned)(Rb * K + C) * 2u; }
    const size_t kstep = (size_t)(BK * 2);
    const size_t hstep = (size_t)HALF * K * 2;
    const size_t tstep = 2 * hstep;
    const unsigned ldsw = (unsigned)wid * 1024u;
    const int aoff = lds_byte(wr * 64 + fr, fq * 8), boff = lds_byte(wc * 32 + fr, fq * 8);
#define PG8_SA(b, h) (((b) * 2 + (h)) * HTB)
#define PG8_SB(b, h) ((4 + (b) * 2 + (h)) * HTB)
#define PG8_STAGE(bufoff, gbase, voff) do { _Pragma("unroll") for (int _i = 0; _i < 2; ++_i) \
        __builtin_amdgcn_global_load_lds((const unsigned*)((const char*)(gbase) + (voff)[_i]), (PG8_LAS unsigned*)(lds + (bufoff) + ldsw + _i * 8192), 16, 0, 0); } while (0)
#define PG8_LDA(dst, b, h) do { _Pragma("unroll") for (int m = 0; m < 4; ++m) _Pragma("unroll") for (int k = 0; k < 2; ++k) dst[m][k] = *(const PG8_LAS bf16x8*)(lds + PG8_SA(b, h) + aoff + m * 2048 + k * 1024); } while (0)
#define PG8_LDB(dst, b, h) do { _Pragma("unroll") for (int n = 0; n < 2; ++n) _Pragma("unroll") for (int k = 0; k < 2; ++k) dst[n][k] = *(const PG8_LAS bf16x8*)(lds + PG8_SB(b, h) + boff + n * 2048 + k * 1024); } while (0)
#define PG8_MMA(ai, bj, At, Bt) do { __builtin_amdgcn_s_setprio(1); _Pragma("unroll") for (int m = 0; m < 4; ++m) _Pragma("unroll") for (int n = 0; n < 2; ++n) _Pragma("unroll") for (int k = 0; k < 2; ++k) \
        acc[ai][bj][m][n] = __builtin_amdgcn_mfma_f32_16x16x32_bf16(Bt[n][k], At[m][k], acc[ai][bj][m][n], 0, 0, 0); __builtin_amdgcn_s_setprio(0); } while (0)
#define PG8_WAIT_V(n) asm volatile("s_waitcnt vmcnt(" #n ")" ::: "memory")
#define PG8_WAIT_L(n) asm volatile("s_waitcnt lgkmcnt(" #n ")" ::: "memory")
#define PG8_BAR __builtin_amdgcn_s_barrier()
#define PG8_SCHED __builtin_amdgcn_sched_barrier(0)
    Unit cur, nxt; int ui = 0;
    if (!S.next(0, cur)) return;
    f32x4 acc[2][2][4][2];
#pragma unroll
    for (int a = 0; a < 2; ++a)
#pragma unroll
        for (int b = 0; b < 2; ++b)
#pragma unroll
            for (int m = 0; m < 4; ++m)
#pragma unroll
                for (int n = 0; n < 2; ++n) acc[a][b][m][n] = (f32x4){0.f, 0.f, 0.f, 0.f};
    bf16x8 At[4][2], B0[2][2], B1[2][2];
    const char* cA = (const char*)g.A + (size_t)cur.pm * tstep; const char* cB = (const char*)g.Bt + (size_t)cur.pn * tstep;
    S.a_ready(cur);
    if constexpr (SP2) {
        PG8_STAGE(PG8_SB(0, 0), cB, voffB); PG8_STAGE(PG8_SB(0, 1), cB + hstep, voffB); PG8_STAGE(PG8_SA(0, 0), cA, voffA); PG8_STAGE(PG8_SA(0, 1), cA + hstep, voffA);
        if (wr == 1) PG8_BAR;
        PG8_WAIT_V(2); PG8_BAR;
        PG8_STAGE(PG8_SB(1, 0), cB + kstep, voffB); PG8_STAGE(PG8_SA(1, 0), cA + kstep, voffA); PG8_STAGE(PG8_SB(1, 1), cB + hstep + kstep, voffB);
        PG8_WAIT_V(6); PG8_BAR;
    } else {
        PG8_STAGE(PG8_SB(0, 0), cB, voffB); PG8_STAGE(PG8_SA(0, 0), cA, voffA); PG8_STAGE(PG8_SB(0, 1), cB + hstep, voffB); PG8_STAGE(PG8_SA(0, 1), cA + hstep, voffA);
        if (wr == 1) PG8_BAR;
        PG8_WAIT_V(4); PG8_BAR;
        PG8_STAGE(PG8_SB(1, 0), cB + kstep, voffB); PG8_STAGE(PG8_SA(1, 0), cA + kstep, voffA); PG8_STAGE(PG8_SB(1, 1), cB + hstep + kstep, voffB);
        PG8_WAIT_V(6); PG8_BAR;
    }
    for (;;) {
        const bool has_next = S.next(ui + 1, nxt);
        const char* nA = has_next ? (const char*)g.A + (size_t)nxt.pm * tstep : cA; const char* nB = has_next ? (const char*)g.Bt + (size_t)nxt.pn * tstep : cB;
        for (int t = 0; t < nt; t += 2) {
            const bool last = (t == nt - 2);
            const char* a1 = cA + (size_t)(t + 1) * kstep;
            const char* a2 = last ? nA : cA + (size_t)(t + 2) * kstep; const char* b2 = last ? nB : cB + (size_t)(t + 2) * kstep;
            const char* a3 = a2 + kstep; const char* b3 = b2 + kstep;
            if (last && has_next) S.a_ready(nxt);
            if constexpr (SP2) {
            PG8_LDB(B0, 0, 0); PG8_LDB(B1, 0, 1); PG8_SCHED; PG8_LDA(At, 0, 0); PG8_STAGE(PG8_SA(1, 1), a1 + hstep, voffA);
            PG8_WAIT_V(8); PG8_WAIT_L(0); PG8_BAR; PG8_MMA(0, 0, At, B0); PG8_MMA(0, 1, At, B1); PG8_BAR; PG8_SCHED;
            PG8_LDA(At, 0, 1); PG8_STAGE(PG8_SB(0, 0), b2, voffB); PG8_STAGE(PG8_SB(0, 1), b2 + hstep, voffB); PG8_STAGE(PG8_SA(0, 0), a2, voffA);
            PG8_WAIT_V(8); PG8_WAIT_L(0); PG8_BAR; PG8_MMA(1, 0, At, B0); PG8_MMA(1, 1, At, B1); PG8_BAR; PG8_SCHED;
            PG8_LDB(B0, 1, 0); PG8_LDB(B1, 1, 1); PG8_SCHED; PG8_LDA(At, 1, 0); PG8_STAGE(PG8_SA(0, 1), a2 + hstep, voffA);
            PG8_WAIT_V(8); PG8_WAIT_L(0); PG8_BAR; PG8_MMA(0, 0, At, B0); PG8_MMA(0, 1, At, B1); PG8_BAR; PG8_SCHED;
            PG8_LDA(At, 1, 1); PG8_STAGE(PG8_SB(1, 0), b3, voffB); PG8_STAGE(PG8_SB(1, 1), b3 + hstep, voffB); PG8_STAGE(PG8_SA(1, 0), a3, voffA);
            PG8_WAIT_V(8); PG8_WAIT_L(0); PG8_BAR; PG8_MMA(1, 0, At, B0); PG8_MMA(1, 1, At, B1); PG8_BAR; PG8_SCHED;
            } else {
            PG8_LDB(B0, 0, 0); PG8_SCHED; PG8_LDA(At, 0, 0); PG8_STAGE(PG8_SA(1, 1), a1 + hstep, voffA);
            PG8_WAIT_L(8); PG8_BAR; PG8_WAIT_L(0); PG8_MMA(0, 0, At, B0); PG8_BAR; PG8_SCHED;
            PG8_LDB(B1, 0, 1); PG8_STAGE(PG8_SB(0, 0), b2, voffB);
            PG8_BAR; PG8_WAIT_L(0); PG8_MMA(0, 1, At, B1); PG8_BAR;
            PG8_LDA(At, 0, 1); PG8_STAGE(PG8_SA(0, 0), a2, voffA);
            PG8_BAR; PG8_WAIT_L(0); PG8_MMA(1, 0, At, B0); PG8_BAR; PG8_SCHED;
            PG8_STAGE(PG8_SB(0, 1), b2 + hstep, voffB);
            PG8_WAIT_V(6); PG8_BAR; PG8_MMA(1, 1, At, B1); PG8_BAR;
            PG8_LDB(B0, 1, 0); PG8_SCHED; PG8_LDA(At, 1, 0); PG8_STAGE(PG8_SA(0, 1), a2 + hstep, voffA);
            PG8_WAIT_L(8); PG8_BAR; PG8_WAIT_L(0); PG8_MMA(0, 0, At, B0); PG8_BAR; PG8_SCHED;
            PG8_LDB(B1, 1, 1); PG8_STAGE(PG8_SB(1, 0), b3, voffB);
            PG8_BAR; PG8_WAIT_L(0); PG8_MMA(0, 1, At, B1); PG8_BAR;
            PG8_LDA(At, 1, 1); PG8_STAGE(PG8_SA(1, 0), a3, voffA);
            PG8_BAR; PG8_WAIT_L(0); PG8_MMA(1, 0, At, B0); PG8_BAR; PG8_SCHED;
            PG8_STAGE(PG8_SB(1, 1), b3 + hstep, voffB);
            PG8_WAIT_V(6); PG8_BAR; PG8_MMA(1, 1, At, B1); PG8_BAR;
            }
        }
        if constexpr (ALIGN_EPI) { if (wr == 0) PG8_BAR; }
        if constexpr (!Epi::AFTER_DRAIN) { E(acc, cur, wr, wc, fr, fq); S.done(cur); }
        if (!has_next) break;
#pragma unroll
        for (int a = 0; a < 2; ++a)
#pragma unroll
            for (int b = 0; b < 2; ++b)
#pragma unroll
                for (int m = 0; m < 4; ++m)
#pragma unroll
                    for (int n = 0; n < 2; ++n) acc[a][b][m][n] = (f32x4){0.f, 0.f, 0.f, 0.f};
        cur = nxt; cA = nA; cB = nB; ++ui;
        if constexpr (ALIGN_EPI) { if (wr == 1) PG8_BAR; }
    }
    PG8_WAIT_V(0);
    if constexpr (!ALIGN_EPI) { if (wr == 0) PG8_BAR; }
    PG8_BAR;
    if constexpr (Epi::AFTER_DRAIN) { E.fused(acc, cur, wr, wc, fr, fq, lds, wid, lane); S.done(cur); }
#undef PG8_SA
#undef PG8_SB
#undef PG8_STAGE
#undef PG8_LDA
#undef PG8_LDB
#undef PG8_MMA
#undef PG8_WAIT_V
#undef PG8_WAIT_L
#undef PG8_BAR
#undef PG8_SCHED
}
}
constexpr int NWAVES = 8;
constexpr int D = 2048, SEQ = 2048, MP = 8192, MS = 64, MT = MP + MS, MPAD = 8448, DEPTH = 4;
constexpr int AW = 1024, NH = 16, HD = 64, CCH = 1024, CK = 31, NIN = 5120, DFF = 5632, NGU = 2 * DFF, NMOD = 6 * D, WBUF = 2048, NBR = 12;
constexpr float EPS = 1e-6f;
constexpr float LOG2E = 1.4426950408889634f;
constexpr float QSCALE = 0.125f * LOG2E;
enum { I_XP = 0, I_XS, I_CP, I_CS, I_CK, I_CV, I_SC, I_GPM, I_GQM, I_GPF, I_GQF, I_WMOD, I_BMOD, I_WIN, I_GAO, I_CW, I_CB, I_LNG, I_LNB, I_WOUT, I_WGU, I_WDN, N_IN };
constexpr size_t O_YP = 0, O_YS = 16777216, O_KP = 16908288, O_VP = 50462720, O_CP = 84017152, O_KS = 84508672, O_VS = 151617536, O_CS = 218726400, O_END = 219709440;
constexpr size_t MiB = 1u << 20;
constexpr size_t WS_CTL = 0, CTL_ZERO_BYTES = 1 * MiB;
constexpr size_t SZ_WIN = (size_t)NIN * D * 2, SZ_WOUT = (size_t)D * D * 2, SZ_WGU = (size_t)NGU * D * 2, SZ_WDN = (size_t)D * DFF * 2;
constexpr size_t WS_WIN = 1 * MiB, WS_WOUT = WS_WIN + DEPTH * SZ_WIN, WS_WGU = WS_WOUT + DEPTH * SZ_WOUT, WS_WDN = WS_WGU + DEPTH * SZ_WGU;
constexpr size_t WS_XRES = WS_WDN + DEPTH * SZ_WDN;
constexpr size_t WS_H = WS_XRES + 65 * MiB;
constexpr size_t WS_Q = WS_H + 33 * MiB, WS_K = WS_Q + 17 * MiB, WS_V = WS_K + 17 * MiB, WS_U = WS_V + 17 * MiB;
constexpr size_t WS_O32 = WS_U + 17 * MiB;
constexpr size_t WS_MIXIN = WS_O32 + 33 * MiB;
constexpr size_t WS_MIX = WS_MIXIN + 33 * MiB;
constexpr size_t WS_FACT = WS_MIX + 33 * MiB;
constexpr size_t WS_F = WS_FACT + 91 * MiB;
constexpr size_t WS_SKP = WS_F + 33 * MiB;
constexpr size_t WS_MODP = WS_SKP + 2 * MiB;
constexpr size_t WS_MOD = WS_MODP + 36 * MiB;
constexpr size_t WS_OB = WS_MOD + 3 * MiB;
constexpr size_t WS_LSE = WS_OB + 49 * MiB;
constexpr size_t WS_YPRE = WS_LSE + 2 * MiB;
constexpr size_t WS_END = WS_YPRE + 17 * MiB;
static_assert(SZ_WIN == 20 * MiB && SZ_WOUT == 8 * MiB && SZ_WGU == 44 * MiB && SZ_WDN == 22 * MiB, "weight sizes");
static_assert((size_t)MT * D * 4 <= 65 * MiB && (size_t)MPAD * D * 2 <= 33 * MiB && (size_t)MPAD * 1024 * 2 <= 17 * MiB && (size_t)MT * 1024 * 4 <= 33 * MiB && (size_t)MPAD * DFF * 2 <= 91 * MiB, "ws map");
static_assert((size_t)16 * DEPTH * 12 * NMOD * 4 <= 36 * MiB && (size_t)DEPTH * 12 * NMOD * 4 <= 3 * MiB, "ws map 2");
constexpr int CW_BAR = 4096;
constexpr int RING_OFF = 0, RING_BYTES = 131072;
constexpr int LDSCTL_OFF = RING_BYTES, MISC_OFF = LDSCTL_OFF + 320;
constexpr int LDS_BYTES = 147456;

#define GAS __attribute__((address_space(1)))
#define LAS __attribute__((address_space(3)))
typedef unsigned short bf16;
typedef unsigned v4u __attribute__((ext_vector_type(4)));
typedef unsigned v2u __attribute__((ext_vector_type(2)));
typedef float f32x4 __attribute__((ext_vector_type(4)));
typedef float f32x2 __attribute__((ext_vector_type(2)));
typedef float f32x16 __attribute__((ext_vector_type(16)));
typedef short bf16x8 __attribute__((ext_vector_type(8)));
typedef GAS unsigned gu32;
#define RLX_AGENT __ATOMIC_RELAXED, __HIP_MEMORY_SCOPE_AGENT
#define LDS_WAIT() asm volatile("s_waitcnt lgkmcnt(0)" ::: "memory")
#define VM_WAIT() asm volatile("s_waitcnt vmcnt(0)" ::: "memory")
__device__ __forceinline__ unsigned f2bf(float f) { unsigned u = __builtin_bit_cast(unsigned, f); return (u + 0x7fffu + ((u >> 16) & 1u)) >> 16; }
__device__ __forceinline__ unsigned pk2(float lo, float hi) { return f2bf(lo) | (f2bf(hi) << 16); }
__device__ __forceinline__ float bflo(unsigned u) { return __builtin_bit_cast(float, u << 16); }
__device__ __forceinline__ float bfhi(unsigned u) { return __builtin_bit_cast(float, u & 0xffff0000u); }
__device__ __forceinline__ float sigm(float x) { return __builtin_amdgcn_rcpf(1.0f + __builtin_amdgcn_exp2f(-LOG2E * x)); }
#define XB_TMO      128
#define XB_XCNT(j)  (256  + 64 * (j))
#define XB_XSUB(j)  (1280 + 64 * (j))
#define XB_XGEN(j)  (2304 + 64 * (j))
#define XB_TOP      3328
#define XB_TOPGEN   3392
#define XCD_BAR_WORDS 3456
#define XB_SPIN_CAP (1u << 18)

__device__ __forceinline__ unsigned xb_ld(unsigned* p)              { return __hip_atomic_load(p, __ATOMIC_RELAXED, __HIP_MEMORY_SCOPE_AGENT); }
__device__ __forceinline__ unsigned xb_add(unsigned* p, unsigned v) { return __hip_atomic_fetch_add(p, v, __ATOMIC_RELAXED, __HIP_MEMORY_SCOPE_AGENT); }
__device__ __forceinline__ unsigned xb_xcc_id() { return (unsigned)__builtin_amdgcn_s_getreg((3 << 11) | 20) & 0xFu; }
#define XB_SPIN(cond, bar) do { unsigned _sp = 0; while (cond) { __builtin_amdgcn_s_sleep(1); \
    if ((++_sp & 255u) == 0u) { if (xb_ld(&(bar)[XB_TMO])) break; if (_sp > XB_SPIN_CAP) { atomicAdd(&(bar)[XB_TMO], 1u); break; } } } } while (0)

struct XcdBarrier {
    unsigned* bar; unsigned x;
    volatile LAS unsigned* st;
};

__device__ __forceinline__ XcdBarrier xcd_barrier_post(unsigned* bar, volatile LAS unsigned* st) {
    XcdBarrier b; b.bar = bar; b.x = xb_xcc_id(); b.st = st;
    if (threadIdx.x == 0) (void)xb_add(&bar[XB_XCNT(b.x)], 1u);
    return b;
}
__device__ __forceinline__ void xcd_barrier_complete(unsigned* bar, unsigned x, unsigned& nloc, unsigned& nx) {
    const unsigned G = gridDim.x * gridDim.y * gridDim.z;
    unsigned sum, cnt, mine, sp = 0u;
    for (;;) {
        sum = 0u; cnt = 0u; mine = 0u;
#pragma unroll
        for (unsigned j = 0; j < 16; ++j) { const unsigned c = xb_ld(&bar[XB_XCNT(j)]); sum += c; cnt += (c > 0u) ? 1u : 0u; mine = (j == x) ? c : mine; }
        if (sum == G) break;
        __builtin_amdgcn_s_sleep(1);
        if ((++sp & 255u) == 0u) { if (xb_ld(&bar[XB_TMO])) break; if (sp > XB_SPIN_CAP) { atomicAdd(&bar[XB_TMO], 1u); break; } }
    }
    nloc = mine > 0u ? mine : 1u; nx = cnt > 0u ? cnt : 1u;
}

__device__ __forceinline__ void xcd_barrier(const XcdBarrier& b) {
    asm volatile("s_waitcnt vmcnt(0)" ::: "memory");
    __syncthreads();
    if (threadIdx.x == 0) {
        unsigned* bar = b.bar; unsigned bx = b.x; asm volatile("" : "+s"(bx));
        __builtin_amdgcn_s_waitcnt(0);
        unsigned nloc = b.st[0], nx = b.st[1];
        if (nloc == 0u) { xcd_barrier_complete(bar, bx, nloc, nx); b.st[0] = nloc; b.st[1] = nx; }
        const unsigned old = xb_add(&bar[XB_XSUB(bx)], 1u);
        const unsigned gen = old / nloc;
        if (old + 1u == (gen + 1u) * nloc) {
            __builtin_amdgcn_fence(__ATOMIC_RELEASE, "agent");
            asm volatile("s_waitcnt vmcnt(0)" ::: "memory");
            const unsigned og = xb_add(&bar[XB_TOP], 1u);
            const unsigned tg = og / nx;
            if (og + 1u == (tg + 1u) * nx) xb_add(&bar[XB_TOPGEN], 1u);
            else XB_SPIN(xb_ld(&bar[XB_TOPGEN]) == tg, bar);
            __builtin_amdgcn_fence(__ATOMIC_ACQUIRE, "agent");
            xb_add(&bar[XB_XGEN(bx)], 1u);
            asm volatile("s_waitcnt vmcnt(0)" ::: "memory");
        } else {
            XB_SPIN(xb_ld(&bar[XB_XGEN(bx)]) == gen, bar);
            __builtin_amdgcn_fence(__ATOMIC_ACQUIRE, "agent");
            asm volatile("s_waitcnt vmcnt(0)" ::: "memory");
        }
    }
    __syncthreads();
}

struct Frame {
    LAS unsigned char* lds;
    volatile LAS unsigned* MISC;
    gu32* ctl;
    int tid, lane, wave, G, bid;
    float* out; unsigned char* ws;
};
__device__ __forceinline__ const float* inp_(const Frame& F, int i) {
    const LAS unsigned* p = (const LAS unsigned*)(F.lds + LDSCTL_OFF) + 2 * i; const unsigned lo = __builtin_amdgcn_readfirstlane(p[0]), hi = __builtin_amdgcn_readfirstlane(p[1]);
    return (const float*)(const GAS float*)(((unsigned long long)hi << 32) | lo);
}
#define INP(i) inp_(F, (i))
__device__ __forceinline__ int launder(int v) { asm volatile("" : "+v"(v)); return v; }
__device__ __forceinline__ int lane_id_now() { int l; asm volatile("v_mbcnt_lo_u32_b32 %0, -1, 0\n\tv_mbcnt_hi_u32_b32 %0, -1, %0" : "=v"(l)); return l; }
__device__ __forceinline__ float wave_sum(float v) {
#pragma unroll
    for (int o = 1; o < 64; o <<= 1) v += __shfl_xor(v, o);
    return v;
}
__device__ __forceinline__ float wave_max(float v) {
#pragma unroll
    for (int o = 1; o < 64; o <<= 1) v = fmaxf(v, __shfl_xor(v, o));
    return v;
}
__device__ __forceinline__ int batch_row(int m) { return m < MP ? (m >> 11) : 4 + ((m - MP) >> 3); }

__device__ __forceinline__ int map_win(int n) { if (n < 3072) return n; if (n < 4096) { const int c = n - 3072; return 3072 + 256 * (c >> 7) + (c & 127); } const int c = n - 4096; return 3072 + 256 * (c >> 7) + 128 + (c & 127); }
__device__ __forceinline__ int map_wgu(int n) { if (n < DFF) return 256 * (n >> 7) + (n & 127); const int c = n - DFF; return 256 * (c >> 7) + 128 + (c & 127); }
template <int MAP>
__device__ __forceinline__ void p0_transpose_item(const float* W, int K, int N, bf16* WT, LAS float* scr, int item, int lane) {
    const int nblk = N / 32, kb = item / nblk, nb = item % nblk, k0 = 64 * kb, n0 = 32 * nb;
    const int d0 = MAP == 1 ? map_win(n0) : (MAP == 2 ? map_wgu(n0) : n0);
    f32x4 wv[8];
#pragma unroll
    for (int i = 0; i < 8; ++i) wv[i] = __builtin_nontemporal_load((const f32x4*)(W + (size_t)(k0 + 8 * i + (lane >> 3)) * N + n0 + 4 * (lane & 7)));
#pragma unroll
    for (int i = 0; i < 8; ++i) { LAS float* d = scr + (8 * i + (lane >> 3)) * 33 + 4 * (lane & 7); d[0] = wv[i].x; d[1] = wv[i].y; d[2] = wv[i].z; d[3] = wv[i].w; }
    LDS_WAIT(); asm volatile("" ::: "memory");
    const int c = lane & 7;
#pragma unroll
    for (int j = 0; j < 4; ++j) { const int n = (lane >> 3) + 8 * j; const LAS float* s = scr + (8 * c) * 33 + n;
        v4u o; o.x = pk2(s[0 * 33], s[1 * 33]); o.y = pk2(s[2 * 33], s[3 * 33]); o.z = pk2(s[4 * 33], s[5 * 33]); o.w = pk2(s[6 * 33], s[7 * 33]);
        *(GAS v4u*)(WT + (size_t)(d0 + n) * K + k0 + 8 * c) = o; }
    LDS_WAIT(); asm volatile("" ::: "memory");
}
__device__ __forceinline__ void p0_transposes(Frame& F) {
    LAS float* scr = (LAS float*)(F.lds + RING_OFF + F.wave * 16384);
    const int gw = F.bid * NWAVES + F.wave, NGW = F.G * NWAVES;
    constexpr int I_IN = (D / 64) * (NIN / 32), I_OUT = (D / 64) * (D / 32), I_GU = (D / 64) * (NGU / 32), I_DN = (DFF / 64) * (D / 32), I_L = I_IN + I_OUT + I_GU + I_DN;
    for (int it = gw; it < DEPTH * I_L; it += NGW) {
        const int l = it / I_L; int r = it % I_L;
        if (r < I_IN) { p0_transpose_item<1>(INP(I_WIN) + (size_t)l * D * NIN, D, NIN, (bf16*)(F.ws + WS_WIN + l * SZ_WIN), scr, r, F.lane); continue; } r -= I_IN;
        if (r < I_OUT) { p0_transpose_item<0>(INP(I_WOUT) + (size_t)l * D * D, D, D, (bf16*)(F.ws + WS_WOUT + l * SZ_WOUT), scr, r, F.lane); continue; } r -= I_OUT;
        if (r < I_GU) { p0_transpose_item<2>(INP(I_WGU) + (size_t)l * D * NGU, D, NGU, (bf16*)(F.ws + WS_WGU + l * SZ_WGU), scr, r, F.lane); continue; } r -= I_GU;
        p0_transpose_item<0>(INP(I_WDN) + (size_t)l * DFF * D, DFF, D, (bf16*)(F.ws + WS_WDN + l * SZ_WDN), scr, r, F.lane);
    }
}
__device__ __forceinline__ void p0_mod_partials(Frame& F) {
    LAS float* cs = (LAS float*)(F.lds + RING_OFF);
    float* modp = (float*)(F.ws + WS_MODP);
    for (int it = F.bid; it < DEPTH * 16 * 6; it += F.G) {
        const int l = it / 96, kc = (it % 96) / 6, nb = it % 6, k0 = kc * 128;
        __syncthreads();
        for (int e = F.tid; e < 12 * 128; e += 512) { const int r = e >> 7, k = e & 127; const float c = r < 4 ? INP(I_CP)[r * D + k0 + k] : INP(I_CS)[(r - 4) * D + k0 + k]; cs[e] = c * sigm(c); }
        __syncthreads();
        const int n = nb * 2048 + F.tid * 4;
        const float* w = INP(I_WMOD) + ((size_t)l * D + k0) * NMOD + n;
        f32x4 acc[12];
#pragma unroll
        for (int r = 0; r < 12; ++r) acc[r] = (f32x4){0.f, 0.f, 0.f, 0.f};
#pragma unroll 4
        for (int k = 0; k < 128; ++k) { const f32x4 wv = __builtin_nontemporal_load((const f32x4*)(w + (size_t)k * NMOD));
#pragma unroll
            for (int r = 0; r < 12; ++r) acc[r] += wv * cs[r * 128 + k]; }
#pragma unroll
        for (int r = 0; r < 12; ++r) *(f32x4*)(modp + (((size_t)kc * DEPTH + l) * 12 + r) * NMOD + n) = acc[r];
    }
    __syncthreads();
}
__device__ __forceinline__ void p0_cache_copy(Frame& F) {
    const size_t nth = (size_t)F.G * 512, gt = (size_t)F.bid * 512 + F.tid;
    constexpr size_t BLK = (size_t)2040 * 1024 / 4;
    { const f32x4* src = (const f32x4*)INP(I_CK); f32x4* dst = (f32x4*)(F.out + O_KS);
        for (size_t i = gt; i < (size_t)32 * BLK; i += nth) { const size_t blk = i / BLK, off = i % BLK;
            const f32x4 v = __builtin_nontemporal_load(src + blk * (2048 * 256) + 8 * 256 + off);
            __builtin_nontemporal_store(v, dst + blk * (2048 * 256) + off); } }
    { const f32x4* src = (const f32x4*)INP(I_CV); f32x4* dst = (f32x4*)(F.out + O_VS);
        for (size_t i = gt; i < (size_t)32 * BLK; i += nth) { const size_t blk = i / BLK, off = i % BLK;
            const f32x4 v = __builtin_nontemporal_load(src + blk * (2048 * 256) + 8 * 256 + off);
            __builtin_nontemporal_store(v, dst + blk * (2048 * 256) + off); } }
}
constexpr int TAIL_SLOTS = 192, TAIL_F4 = 43520, BLK_F4 = 522240;
static_assert((long)TAIL_SLOTS * TAIL_F4 == 16L * BLK_F4, "tail copy slots cover the layer's window copy exactly");
__device__ __forceinline__ void tail_copy(Frame& F, int l, int slot) {
    const f32x4* sk = (const f32x4*)INP(I_CK); const f32x4* sv = (const f32x4*)INP(I_CV); f32x4* dk = (f32x4*)(F.out + O_KS); f32x4* dv = (f32x4*)(F.out + O_VS);
    const int tid = F.tid;
    for (int k0 = 0; k0 < TAIL_F4 / 512; k0 += 17) {
        f32x4 v[17]; size_t dofs[17]; int ts[17];
#pragma unroll
        for (int k = 0; k < 17; ++k) {
            const int i = slot * TAIL_F4 + (k0 + k) * 512 + tid, t = i / (8 * BLK_F4), rem = i % (8 * BLK_F4), blk = rem / BLK_F4, off = rem % BLK_F4;
            const size_t so = ((size_t)(l * 8 + blk) * 2048 + 8) * 256 + off; dofs[k] = (size_t)(l * 8 + blk) * 2048 * 256 + off; ts[k] = t;
            v[k] = __builtin_nontemporal_load((t ? sv : sk) + so);
        }
        __builtin_amdgcn_sched_barrier(0);
#pragma unroll
        for (int k = 0; k < 17; ++k) __builtin_nontemporal_store(v[k], (ts[k] ? dv : dk) + dofs[k]);
    }
}
__device__ __forceinline__ void p0_mod_reduce(Frame& F) {
    const float* modp = (const float*)(F.ws + WS_MODP); bf16* modb = (bf16*)(F.ws + WS_MOD);
    const int total = DEPTH * 12 * NMOD / 4;
    for (int i = F.bid * 512 + F.tid; i < total; i += F.G * 512) {
        const int e = i * 4, l = e / (12 * NMOD), n = e % NMOD, ch = n >> 11, c = n & 2047;
        f32x4 s = *(const f32x4*)(INP(I_BMOD) + (size_t)l * NMOD + n);
#pragma unroll
        for (int kc = 0; kc < 16; ++kc) s += *(const f32x4*)(modp + (size_t)kc * DEPTH * 12 * NMOD + e);
        if (ch == 1) s = (s + 1.0f) * *(const f32x4*)(INP(I_GPM) + (size_t)l * D + c);
        else if (ch == 2) s = s * *(const f32x4*)(INP(I_GQM) + (size_t)l * D + c);
        else if (ch == 4) s = (s + 1.0f) * *(const f32x4*)(INP(I_GPF) + (size_t)l * D + c);
        else if (ch == 5) s = s * *(const f32x4*)(INP(I_GQF) + (size_t)l * D + c);
        v2u w; w.x = pk2(s.x, s.y); w.y = pk2(s.z, s.w); *(v2u*)(modb + e) = w;
    }
}
#define UNP(v) ((f32x4){bflo((v).x), bfhi((v).x), bflo((v).y), bfhi((v).y)})
template <bool HAS_DELTA, bool XIN_F32, bool PROMPT = true>
__device__ __forceinline__ void resnorm_rows(Frame& F, const float* xin_p, const float* xin_s, float* out32_p, float* out32_s, const bf16* dbf, const float* dpart,
                                             const bf16* mgate, const bf16* msc, const bf16* msh, bf16* hb, unsigned* sig = nullptr) {
    bf16* XR = (bf16*)(F.ws + WS_XRES);
    const int gw = F.bid * NWAVES + F.wave, lane = F.lane;
    if (PROMPT) for (int m0 = 4 * gw; m0 < MP; m0 += 4 * F.G * NWAVES) {
        const int br = m0 >> 11;
        v4u v1[4], v2[4], v3[4];
#pragma unroll
        for (int j = 0; j < 4; ++j) { const int c = 8 * lane + 512 * j;
            if (HAS_DELTA) v1[j] = *(const v4u*)(mgate + (size_t)br * NMOD + c);
            if (hb) { v2[j] = *(const v4u*)(msc + (size_t)br * NMOD + c); v3[j] = *(const v4u*)(msh + (size_t)br * NMOD + c); } }
        f32x4 xf[2][4][2]; v4u xq[2][4], dq[2][4];
#define UNL(v) ((f32x4){bflo((v).x), bfhi((v).x), bflo((v).y), bfhi((v).y)})
#define UNH(v) ((f32x4){bflo((v).z), bfhi((v).z), bflo((v).w), bfhi((v).w)})
#define LOADROW(buf, mm) do { _Pragma("unroll") for (int j = 0; j < 4; ++j) { const size_t o_ = (size_t)(mm) * D + 8 * lane + 512 * j; \
            if (XIN_F32) { xf[buf][j][0] = __builtin_nontemporal_load((const f32x4*)(xin_p + o_)); xf[buf][j][1] = __builtin_nontemporal_load((const f32x4*)(xin_p + o_ + 4)); } \
            else xq[buf][j] = __builtin_nontemporal_load((const v4u*)(XR + o_)); \
            if (HAS_DELTA) dq[buf][j] = __builtin_nontemporal_load((const v4u*)(dbf + o_)); } } while (0)
        LOADROW(0, m0);
#pragma unroll
        for (int i = 0; i < 4; ++i) {
            const int m = m0 + i, cur = i & 1;
            if (i < 3) LOADROW(cur ^ 1, m + 1);
            __builtin_amdgcn_sched_barrier(0);
#pragma unroll
            for (int j = 0; j < 4; ++j) { asm volatile("" : "+v"(v1[j]), "+v"(v2[j]), "+v"(v3[j])); }
            f32x4 x[4][2];
#pragma unroll
            for (int j = 0; j < 4; ++j) { x[j][0] = XIN_F32 ? xf[cur][j][0] : UNL(xq[cur][j]); x[j][1] = XIN_F32 ? xf[cur][j][1] : UNH(xq[cur][j]); }
            if (HAS_DELTA) {
                float ss = 0.f;
#pragma unroll
                for (int j = 0; j < 4; ++j) { const f32x4 t = UNL(dq[cur][j]), u = UNH(dq[cur][j]); ss += ((t.x * t.x + t.y * t.y) + (t.z * t.z + t.w * t.w)) + ((u.x * u.x + u.y * u.y) + (u.z * u.z + u.w * u.w)); }
                const float r = 1.0f / sqrtf(wave_sum(ss) * (1.0f / D) + EPS);
#pragma unroll
                for (int j = 0; j < 4; ++j) { x[j][0] = x[j][0] + UNL(v1[j]) * (UNL(dq[cur][j]) * r); x[j][1] = x[j][1] + UNH(v1[j]) * (UNH(dq[cur][j]) * r); }
            }
            if (out32_p) {
#pragma unroll
                for (int j = 0; j < 4; ++j) { float* o = out32_p + (size_t)m * D + 8 * lane + 512 * j; *(f32x4*)o = x[j][0]; *(f32x4*)(o + 4) = x[j][1]; }
            } else {
#pragma unroll
                for (int j = 0; j < 4; ++j) { v4u w; w.x = pk2(x[j][0].x, x[j][0].y); w.y = pk2(x[j][0].z, x[j][0].w); w.z = pk2(x[j][1].x, x[j][1].y); w.w = pk2(x[j][1].z, x[j][1].w);
                    __builtin_nontemporal_store(w, (v4u*)(XR + (size_t)m * D + 8 * lane + 512 * j)); }
            }
            if (hb) {
                float ss = 0.f;
#pragma unroll
                for (int j = 0; j < 4; ++j) { const f32x4 t = x[j][0], u = x[j][1]; ss += ((t.x * t.x + t.y * t.y) + (t.z * t.z + t.w * t.w)) + ((u.x * u.x + u.y * u.y) + (u.z * u.z + u.w * u.w)); }
                const float r = 1.0f / sqrtf(wave_sum(ss) * (1.0f / D) + EPS);
#pragma unroll
                for (int j = 0; j < 4; ++j) { const f32x4 h0 = x[j][0] * r * UNL(v2[j]) + UNL(v3[j]), h1 = x[j][1] * r * UNH(v2[j]) + UNH(v3[j]);
                    v4u w; w.x = pk2(h0.x, h0.y); w.y = pk2(h0.z, h0.w); w.z = pk2(h1.x, h1.y); w.w = pk2(h1.z, h1.w); *(v4u*)(hb + (size_t)m * D + 8 * lane + 512 * j) = w; }
            }
        }
#undef LOADROW
#undef UNL
#undef UNH
    }
    for (int it = F.G - 1 - F.bid; it < MS / 4; it += F.G) {
        LAS float* red = (LAS float*)(F.lds + RING_OFF);
        const int ms0 = it * 4, br = 4 + (ms0 >> 3), c = 4 * F.tid;
        f32x4 x[4], d[4];
#pragma unroll
        for (int i = 0; i < 4; ++i) { const size_t o = (size_t)(ms0 + i) * D + c;
            if (XIN_F32) x[i] = *(const f32x4*)(xin_s + o); else { const v2u q = *(const v2u*)(XR + (size_t)MP * D + o); x[i] = UNP(q); }
            if (HAS_DELTA) { f32x4 s = *(const f32x4*)(dpart + o);
#pragma unroll
                for (int q = 1; q < 4; ++q) s += *(const f32x4*)(dpart + (size_t)q * MS * D + o);
                d[i] = s; } }
        __syncthreads();
        if (HAS_DELTA) {
            const v2u g1 = *(const v2u*)(mgate + (size_t)br * NMOD + c);
#pragma unroll
            for (int i = 0; i < 4; ++i) { const float s = wave_sum((d[i].x * d[i].x + d[i].y * d[i].y) + (d[i].z * d[i].z + d[i].w * d[i].w)); if (lane == 0) red[i * 8 + F.wave] = s; }
            __syncthreads();
#pragma unroll
            for (int i = 0; i < 4; ++i) { const f32x4 a = *(const LAS f32x4*)(red + i * 8), b = *(const LAS f32x4*)(red + i * 8 + 4);
                const float r = 1.0f / sqrtf(((a.x + a.y) + (a.z + a.w) + (b.x + b.y) + (b.z + b.w)) * (1.0f / D) + EPS);
                x[i] = x[i] + UNP(g1) * (d[i] * r); }
        }
#pragma unroll
        for (int i = 0; i < 4; ++i) { const size_t o = (size_t)(ms0 + i) * D + c;
            if (out32_s) *(f32x4*)(out32_s + o) = x[i]; else { v2u w; w.x = pk2(x[i].x, x[i].y); w.y = pk2(x[i].z, x[i].w); *(v2u*)(XR + (size_t)MP * D + o) = w; } }
        if (hb) {
            const v2u g2 = *(const v2u*)(msc + (size_t)br * NMOD + c), g3 = *(const v2u*)(msh + (size_t)br * NMOD + c);
#pragma unroll
            for (int i = 0; i < 4; ++i) { const float s = wave_sum((x[i].x * x[i].x + x[i].y * x[i].y) + (x[i].z * x[i].z + x[i].w * x[i].w)); if (lane == 0) red[32 + i * 8 + F.wave] = s; }
            __syncthreads();
#pragma unroll
            for (int i = 0; i < 4; ++i) { const f32x4 a = *(const LAS f32x4*)(red + 32 + i * 8), b = *(const LAS f32x4*)(red + 32 + i * 8 + 4);
                const float r = 1.0f / sqrtf(((a.x + a.y) + (a.z + a.w) + (b.x + b.y) + (b.z + b.w)) * (1.0f / D) + EPS);
                const f32x4 h = x[i] * r * UNP(g2) + UNP(g3);
                __hip_atomic_store((unsigned long long*)(hb + (size_t)(MP + ms0 + i) * D + c), ((unsigned long long)pk2(h.z, h.w) << 32) | (unsigned long long)pk2(h.x, h.y), __ATOMIC_RELAXED, __HIP_MEMORY_SCOPE_AGENT); }
        }
        if (sig) asm volatile("s_waitcnt vmcnt(0)" ::: "memory");
        __syncthreads();
        if (sig && F.tid == 0) __hip_atomic_fetch_add(sig, 1u, __ATOMIC_RELAXED, __HIP_MEMORY_SCOPE_AGENT);
    }
}
#undef UNP
__device__ __forceinline__ void attn_sample_item(Frame& F, int l, int it, LAS float* pscr) {
    const int br = it % 3, mh = it / 3, ms = mh >> 4, h = mh & 15, b = ms >> 3, m = MP + ms, dsh = 2 * br, lane = F.lane;
    const bf16* Qb = (const bf16*)(F.ws + WS_Q); const bf16* Kb = (const bf16*)(F.ws + WS_K); const bf16* Vb = (const bf16*)(F.ws + WS_V);
    bf16* OB = (bf16*)(F.ws + WS_OB) + (size_t)br * MT * 1024; float* LSE = (float*)(F.ws + WS_LSE) + (size_t)br * MT * 16;
    const int tpos = WBUF + (ms & 7);
    const float slope2 = exp2f(-0.5f * (float)(h + 1)) * LOG2E;
    const float* ck = INP(I_CK) + ((size_t)(l * 8 + b) * WBUF) * 1024 + h * 64;
    const float* cv = INP(I_CV) + ((size_t)(l * 8 + b) * WBUF) * 1024 + h * 64;
    const bf16* kn = Kb + (size_t)(MP + b * 8) * 1024 + h * 64;
    const bf16* vn = Vb + (size_t)(MP + b * 8) * 1024 + h * 64;
    v4u qv[8];
#pragma unroll
    for (int c = 0; c < 8; ++c) qv[c] = *(const v4u*)(Qb + (size_t)m * 1024 + h * 64 + 8 * c);
    const int d0 = lane << dsh, d1 = (lane + 64) << dsh, i0 = tpos - d0, i1 = tpos - d1, i128 = tpos - (128 << dsh);
    const bool old0 = i0 < WBUF;
    const float* kr0 = ck + (size_t)(old0 ? i0 : WBUF - 1) * 1024; const float* kr1 = ck + (size_t)i1 * 1024; const bf16* kq0 = kn + (size_t)(old0 ? 0 : i0 - WBUF) * 1024;
    f32x4 ka[16], kb[16]; v4u kn8[8];
#pragma unroll
    for (int c = 0; c < 16; ++c) { ka[c] = *(const f32x4*)(kr0 + 4 * c); kb[c] = *(const f32x4*)(kr1 + 4 * c); }
#pragma unroll
    for (int c = 0; c < 8; ++c) kn8[c] = *(const v4u*)(kq0 + 8 * c);
    const float k128 = ck[(size_t)i128 * 1024 + lane]; const float q128 = bflo((unsigned)Qb[(size_t)m * 1024 + h * 64 + lane]);
    __builtin_amdgcn_sched_barrier(0);
    float a0 = 0.f, a1 = 0.f, an = 0.f;
#pragma unroll
    for (int c = 0; c < 8; ++c) { const v4u q = qv[c]; const f32x4 x0 = ka[2 * c], x1 = ka[2 * c + 1], y0 = kb[2 * c], y1 = kb[2 * c + 1]; const v4u k = kn8[c];
        a0 += bflo(q.x) * x0.x + bfhi(q.x) * x0.y + bflo(q.y) * x0.z + bfhi(q.y) * x0.w + bflo(q.z) * x1.x + bfhi(q.z) * x1.y + bflo(q.w) * x1.z + bfhi(q.w) * x1.w;
        a1 += bflo(q.x) * y0.x + bfhi(q.x) * y0.y + bflo(q.y) * y0.z + bfhi(q.y) * y0.w + bflo(q.z) * y1.x + bfhi(q.z) * y1.y + bflo(q.w) * y1.z + bfhi(q.w) * y1.w;
        an += bflo(q.x) * bflo(k.x) + bfhi(q.x) * bfhi(k.x) + bflo(q.y) * bflo(k.y) + bfhi(q.y) * bfhi(k.y) + bflo(q.z) * bflo(k.z) + bfhi(q.z) * bfhi(k.z) + bflo(q.w) * bflo(k.w) + bfhi(q.w) * bfhi(k.w); }
    const float s0 = (old0 ? a0 : an) - slope2 * (float)d0, s1 = a1 - slope2 * (float)d1;
    const float s128 = wave_sum(k128 * q128) - slope2 * (float)(128 << dsh);
    const float mx = fmaxf(wave_max(fmaxf(s0, s1)), s128);
    const float p0 = __builtin_amdgcn_exp2f(s0 - mx), p1 = __builtin_amdgcn_exp2f(s1 - mx), p128 = __builtin_amdgcn_exp2f(s128 - mx);
    const float sum = wave_sum(p0 + p1) + p128, inv = 1.0f / sum;
    pscr[lane] = p0 * inv; pscr[64 + lane] = p1 * inv; if (lane < 4) pscr[128 + lane] = lane == 0 ? p128 * inv : 0.f;
    LDS_WAIT(); asm volatile("" ::: "memory");
    const int ks = lane >> 4, dq = lane & 15;
    f32x4 vc[33]; v2u vw[2];
#pragma unroll
    for (int jt = 0; jt < 33; ++jt) { const int j = 4 * jt + ks; int idx = tpos - (j << dsh); idx = idx < 0 ? 0 : (idx >= WBUF ? WBUF - 1 : idx);
        vc[jt] = *(const f32x4*)(cv + (size_t)idx * 1024 + 4 * dq); }
#pragma unroll
    for (int jt = 0; jt < 2; ++jt) { const int j = 4 * jt + ks; const int idx = tpos - (j << dsh); vw[jt] = *(const v2u*)(vn + (size_t)(idx >= WBUF ? idx - WBUF : 0) * 1024 + 4 * dq); }
    __builtin_amdgcn_sched_barrier(0);
    f32x4 acc = (f32x4){0.f, 0.f, 0.f, 0.f};
#pragma unroll
    for (int jt = 0; jt < 33; ++jt) { const int j = 4 * jt + ks; const float p = pscr[j]; f32x4 v = vc[jt];
        if (jt < 2) { const int idx = tpos - (j << dsh); if (idx >= WBUF) v = (f32x4){bflo(vw[jt].x), bfhi(vw[jt].x), bflo(vw[jt].y), bfhi(vw[jt].y)}; }
        acc += v * p; }
#pragma unroll
    for (int e = 0; e < 4; ++e) { acc[e] += __shfl_xor(acc[e], 16); acc[e] += __shfl_xor(acc[e], 32); }
    if (lane < 16) { v2u w; w.x = pk2(acc.x, acc.y); w.y = pk2(acc.z, acc.w); *(v2u*)(OB + (size_t)m * 1024 + h * 64 + 4 * dq) = w; }
    if (lane == 0) LSE[(size_t)m * 16 + h] = mx + __builtin_amdgcn_logf(sum);
    LDS_WAIT(); asm volatile("" ::: "memory");
}
__device__ __forceinline__ void attn_sample_phase(Frame& F, int l) {
    LAS float* pscr = (LAS float*)(F.lds + RING_OFF + F.wave * 16384);
    const int gwr = ((F.bid + F.G - 8) % F.G) * NWAVES + F.wave, NGW = F.G * NWAVES;
    for (int it = gwr; it < MS * NH * 3; it += NGW) attn_sample_item(F, l, it, pscr);
}
typedef const __attribute__((address_space(3))) char* lds_cptr;
typedef short v4i16_t __attribute__((ext_vector_type(4)));
typedef short s16x4 __attribute__((ext_vector_type(4)));
__device__ __forceinline__ s16x4 vtr(lds_cptr p) { return __builtin_bit_cast(s16x4, __builtin_amdgcn_ds_read_tr16_b64_v4i16((__attribute__((address_space(3))) v4i16_t*)p)); }
__device__ __forceinline__ unsigned cvtpk(float lo, float hi) { typedef float f2 __attribute__((ext_vector_type(2))); typedef __bf16 b2 __attribute__((ext_vector_type(2))); f2 v = {lo, hi}; b2 b = __builtin_convertvector(v, b2); return __builtin_bit_cast(unsigned, b); }
__device__ __forceinline__ void glds16(const void* gsrc, unsigned lds_dst) { unsigned keep;
    asm volatile("s_mov_b32 %0, m0\n\ts_mov_b32 m0, %2\n\ts_nop 0\n\tglobal_load_lds_dwordx4 %1, off\n\ts_mov_b32 m0, %0" : "=&s"(keep) : "v"(gsrc), "s"(lds_dst) : "memory"); }
struct AttnC { int br, dsh, r, qb, h; size_t rowb; };
__device__ __forceinline__ AttnC attn_coord(int w, int wave) {
    AttnC c; c.br = w >> 9; const int bh = (w & 511) >> 3, e = (w & 7) * 8 + wave, sh = 6 - 2 * c.br;
    c.dsh = 2 * c.br; c.r = e >> sh; c.qb = e & ((1 << sh) - 1); c.h = bh & 15; c.rowb = (size_t)(bh >> 4) * SEQ; return c;
}
__device__ __forceinline__ void attn_load_q(const Frame& F, const AttnC& c, int lane, bf16x8 (&qf)[4]) {
    const bf16* Qb = (const bf16*)(F.ws + WS_Q); const int r32 = lane & 31, hi = lane >> 5;
    const int tq = ((32 * c.qb + r32) << c.dsh) + c.r;
#pragma unroll
    for (int s = 0; s < 4; ++s) qf[s] = *(const bf16x8*)(Qb + (c.rowb + tq) * 1024 + c.h * 64 + 16 * s + 8 * hi);
}
template <int KB0, int KB1>
__device__ __forceinline__ void attn_load_k(const Frame& F, const AttnC& c, int lane, bf16x8 (&kf)[5][4]) {
    const bf16* Kb = (const bf16*)(F.ws + WS_K); const int r32 = lane & 31, hi = lane >> 5;
#pragma unroll
    for (int kb = KB0; kb < KB1; ++kb) {
        int ap = 32 * (c.qb - 4 + kb) + r32; ap = ap < 0 ? 0 : ap;
        const bf16* kr = Kb + (c.rowb + (size_t)((ap << c.dsh) + c.r)) * 1024 + c.h * 64 + 8 * hi;
#pragma unroll
        for (int s = 0; s < 4; ++s) kf[kb][s] = *(const bf16x8*)(kr + 16 * s);
    }
}
template <bool VISIBLE>
__device__ __forceinline__ void attn_v_dma(const Frame& F, const AttnC& c, int lane, LAS unsigned char* wl, int kb, int slot) {
    const bf16* Vb = (const bf16*)(F.ws + WS_V); const int vkey = (lane & 31) >> 2, vch = 4 * (lane >> 5) + (lane & 3);
#pragma unroll
    for (int i = 0; i < 4; ++i) { int ap = 32 * (c.qb - 4 + kb) + 8 * i + vkey; ap = ap < 0 ? 0 : ap;
        const bf16* src = Vb + (c.rowb + (size_t)((ap << c.dsh) + c.r)) * 1024 + c.h * 64 + vch * 8;
        if (VISIBLE) __builtin_amdgcn_global_load_lds((const unsigned*)src, (LAS unsigned*)(wl + slot * 4096 + i * 1024), 16, 0, 0);
        else glds16(src, (unsigned)__builtin_amdgcn_readfirstlane((unsigned)(uintptr_t)wl + slot * 4096 + i * 1024)); }
}
__device__ __forceinline__ AttnC attn_coord_i(int I) {
    AttnC c; c.br = I >> 12; const int rem = I & 4095, bh = rem >> 6, e = rem & 63, sh = 6 - 2 * c.br;
    c.dsh = 2 * c.br; c.r = e >> sh; c.qb = e & ((1 << sh) - 1); c.h = bh & 15; c.rowb = (size_t)(bh >> 4) * SEQ; return c;
}
__device__ __forceinline__ void attn_qk(const bf16x8 (&qf)[4], const bf16x8 (&kf)[5][4], float c1, f32x16 (&S)[5]) {
#pragma unroll
    for (int kb = 0; kb < 5; ++kb) {
        f32x16 acc;
#pragma unroll
        for (int i = 0; i < 16; ++i) acc[i] = c1;
#pragma unroll
        for (int s = 0; s < 4; ++s) acc = __builtin_amdgcn_mfma_f32_32x32x16_bf16(kf[kb][s], qf[s], acc, 0, 0, 0);
        S[kb] = acc;
    }
}
__device__ __forceinline__ float attn_sd(const AttnC& c) { return exp2f(-0.5f * (float)(c.h + 1)) * LOG2E * (float)(1 << c.dsh); }
#define ATTN_W(n) asm volatile("s_waitcnt vmcnt(" #n ")" ::: "memory")
__device__ __forceinline__ void attn_mfma_phase(Frame& F) {
    LAS unsigned char* wl = F.lds + RING_OFF + F.wave * 16384;
    const int lane = F.lane, r32 = lane & 31, hi = lane >> 5;
    constexpr int NITEM = 3 * 64 * 64;
    const int NW = F.G * NWAVES, per = (NITEM + NW - 1) / NW;
    int I = (F.bid * NWAVES + F.wave) * per; asm volatile("" : "+s"(I));
    const int Iend = (I + per < NITEM) ? I + per : NITEM;
    if (I >= Iend) return;
    f32x16 S[5]; bf16x8 kf[5][4];
    { const AttnC c = attn_coord_i(I); bf16x8 qf[4];
      attn_load_q(F, c, lane, qf); attn_load_k<0, 5>(F, c, lane, kf);
#pragma unroll
      for (int kb = 0; kb < 4; ++kb) attn_v_dma<false>(F, c, lane, wl, kb, (c.qb - 4 + kb) & 3);
      attn_qk(qf, kf, attn_sd(c) * (float)(4 * hi - 128 - r32), S); }
    bool restart = true;
#pragma unroll 1
    for (;;) {
        const AttnC c = attn_coord_i(I);
        const bool has_next = I + 1 < Iend, same = has_next && (((I + 1) & ((64 >> c.dsh) - 1)) != 0);
        const int qb = c.qb;
        const float sd = attn_sd(c);
        bf16* OB = (bf16*)(F.ws + WS_OB) + (size_t)c.br * MT * 1024; float* LSE = (float*)(F.ws + WS_LSE) + (size_t)c.br * MT * 16;
        const int tq = ((32 * qb + r32) << c.dsh) + c.r;
        if (has_next) { int In = I + 1; asm volatile("" : "+s"(In)); const AttnC cn = attn_coord_i(In);
            if (same) {
#pragma unroll
                for (int kb = 0; kb < 4; ++kb)
#pragma unroll
                    for (int s = 0; s < 4; ++s) kf[kb][s] = kf[kb + 1][s];
                attn_load_k<4, 5>(F, cn, lane, kf);
            } else attn_load_k<0, 5>(F, cn, lane, kf);
        }
        __builtin_amdgcn_sched_barrier(0);
        float mx = -INFINITY;
#pragma unroll
        for (int kb = 0; kb < 5; ++kb) {
            const bool blk_ok = (qb - 4 + kb) >= 0;
#pragma unroll
            for (int i = 0; i < 16; ++i) { const int ikb = (i & 3) + 8 * (i >> 2), ik = ikb + 4 * hi;
                float s = S[kb][i] + sd * (float)(32 * kb + ikb);
                bool ok = blk_ok;
                if (kb == 0) ok = ok && (ik >= r32);
                if (kb == 4) ok = ok && (ik <= r32);
                s = ok ? s : -INFINITY; S[kb][i] = s; mx = fmaxf(mx, s); }
        }
        mx = fmaxf(mx, __shfl_xor(mx, 32));
        float l = 0.f;
        f32x16 O[2];
#pragma unroll
        for (int i = 0; i < 16; ++i) { O[0][i] = 0.f; O[1][i] = 0.f; }
        const lds_cptr vb = (lds_cptr)wl + (4 * hi + ((lane >> 2) & 3)) * 64 + ((lane >> 4) & 1) * 32 + (lane & 3) * 8;
        bf16x8 qn[4];
#pragma unroll
        for (int kb = 0; kb < 5; ++kb) {
            const int slot = (qb - 4 + kb) & 3;
            bf16x8 pf[2];
#pragma unroll
            for (int i = 0; i < 16; ++i) { const float p = __builtin_amdgcn_exp2f(S[kb][i] - mx); S[kb][i] = p; l += p; }
#pragma unroll
            for (int s = 0; s < 2; ++s) { v4u wv; wv.x = cvtpk(S[kb][8 * s + 0], S[kb][8 * s + 1]); wv.y = cvtpk(S[kb][8 * s + 2], S[kb][8 * s + 3]); wv.z = cvtpk(S[kb][8 * s + 4], S[kb][8 * s + 5]); wv.w = cvtpk(S[kb][8 * s + 6], S[kb][8 * s + 7]);
                pf[s] = __builtin_bit_cast(bf16x8, wv); }
            if (kb == 0 && restart) { if (!has_next) ATTN_W(0); else if (same) ATTN_W(4); else ATTN_W(20); }
            if (kb == 4) ATTN_W(0);
            const lds_cptr vs = vb + slot * 4096;
#pragma unroll
            for (int s = 0; s < 2; ++s)
#pragma unroll
                for (int dt = 0; dt < 2; ++dt) { const s16x4 lo = vtr(vs + s * 2048 + dt * 512), hh = vtr(vs + s * 2048 + dt * 512 + 1024);
                    const bf16x8 vf = (bf16x8){lo[0], lo[1], lo[2], lo[3], hh[0], hh[1], hh[2], hh[3]};
                    O[dt] = __builtin_amdgcn_mfma_f32_32x32x16_bf16(vf, pf[s], O[dt], 0, 0, 0); }
            if (kb == 0) { asm volatile("s_waitcnt lgkmcnt(0)" ::: "memory"); attn_v_dma<false>(F, c, lane, wl, 4, qb & 3);
                if (has_next) { int In = I + 1; asm volatile("" : "+s"(In)); attn_load_q(F, attn_coord_i(In), lane, qn); } }
        }
        l += __shfl_xor(l, 32);
        const float inv = 1.0f / l;
        bf16* orow = OB + (c.rowb + tq) * 1024 + c.h * 64 + 4 * hi;
#pragma unroll
        for (int dt = 0; dt < 2; ++dt)
#pragma unroll
            for (int g = 0; g < 4; ++g) { v2u wv; wv.x = cvtpk(O[dt][4 * g + 0] * inv, O[dt][4 * g + 1] * inv); wv.y = cvtpk(O[dt][4 * g + 2] * inv, O[dt][4 * g + 3] * inv);
                *(v2u*)(orow + 32 * dt + 8 * g) = wv; }
        if (hi == 0) LSE[(c.rowb + tq) * 16 + c.h] = mx + __builtin_amdgcn_logf(l);
        asm volatile("s_waitcnt lgkmcnt(0)" ::: "memory");
        if (!has_next) break;
        ++I; asm volatile("" : "+s"(I));
        { const AttnC cn = attn_coord_i(I);
          if (!same) {
#pragma unroll
              for (int kb = 0; kb < 4; ++kb) attn_v_dma<false>(F, cn, lane, wl, kb, (cn.qb - 4 + kb) & 3);
          }
          restart = !same;
          attn_qk(qn, kf, attn_sd(cn) * (float)(4 * hi - 128 - r32), S); }
    }
    asm volatile("s_waitcnt vmcnt(0) lgkmcnt(0)" ::: "memory");
}
#undef ATTN_W
template <int NTOK, bool SAMPLE>
__device__ __forceinline__ void conv_run(Frame& F, int l, int b, int t0, const f32x2 (&w)[CK], const f32x2 bias, int c) {
    const bf16* Ub = (const bf16*)(F.ws + WS_U); bf16* YP = (bf16*)(F.ws + WS_YPRE);
    unsigned ue[NTOK + 30];
#pragma unroll
    for (int j = 0; j < NTOK + 30; ++j) {
        if (SAMPLE) { if (j < 30) { const f32x2 v = *(const f32x2*)(INP(I_SC) + ((size_t)(l * 8 + b) * 30 + j) * CCH + c); ue[j] = pk2(v.x, v.y); }
                      else ue[j] = *(const unsigned*)(Ub + (size_t)(MP + b * 8 + j - 30) * 1024 + c); }
        else { const int t = t0 - 30 + j; ue[j] = t < 0 ? 0u : *(const unsigned*)(Ub + (size_t)(b * SEQ + t) * 1024 + c); }
    }
    if (SAMPLE) { float* co = F.out + O_CS + (size_t)(l * 8 + b) * 30 * CCH + c;
#pragma unroll
        for (int j = 0; j < 30; ++j) { f32x2 v; if (j + 8 < 30) v = *(const f32x2*)(INP(I_SC) + ((size_t)(l * 8 + b) * 30 + j + 8) * CCH + c); else v = (f32x2){bflo(ue[j + 8]), bfhi(ue[j + 8])}; *(f32x2*)(co + (size_t)j * CCH) = v; }
    } else if (t0 + NTOK == SEQ) { float* co = F.out + O_CP + (size_t)(l * 4 + b) * 30 * CCH + c;
#pragma unroll
        for (int j = 0; j < 30; ++j) { const unsigned v = ue[j + NTOK]; *(f32x2*)(co + (size_t)j * CCH) = (f32x2){bflo(v), bfhi(v)}; }
    }
    f32x2 uf[NTOK + 30];
#pragma unroll
    for (int j = 0; j < NTOK + 30; ++j) uf[j] = (f32x2){bflo(ue[j]), bfhi(ue[j])};
#pragma unroll
    for (int t = 0; t < NTOK; ++t) { f32x2 a = bias;
#pragma unroll
        for (int k = 0; k < CK; ++k) a += w[k] * uf[t + k];
        const size_t row = SAMPLE ? (size_t)(MP + b * 8 + t) : (size_t)(b * SEQ + t0 + t);
        *(unsigned*)(YP + row * 1024 + c) = pk2(a.x, a.y); }
}
__device__ __forceinline__ void conv_phase(Frame& F, int l) {
    const int c = F.wave * 128 + 2 * F.lane;
    f32x2 w[CK];
#pragma unroll
    for (int k = 0; k < CK; ++k) w[k] = *(const f32x2*)(INP(I_CW) + ((size_t)l * CK + k) * CCH + c);
    const f32x2 bias = *(const f32x2*)(INP(I_CB) + (size_t)l * CCH + c);
    for (int it = F.bid; it < 512 + 8; it += F.G) {
        if (it < 512) conv_run<16, false>(F, l, it >> 7, (it & 127) * 16, w, bias, c);
        else conv_run<8, true>(F, l, it - 512, 0, w, bias, c);
    }
}
__device__ __forceinline__ void onorm_phase(Frame& F, int l) {
    bf16* MIXIN = (bf16*)(F.ws + WS_MIXIN); const float* g = INP(I_GAO) + (size_t)l * AW;
    const bf16* OB = (const bf16*)(F.ws + WS_OB); const float* LSE = (const float*)(F.ws + WS_LSE); const bf16* YP = (const bf16*)(F.ws + WS_YPRE);
    const float* lng = INP(I_LNG) + (size_t)l * CCH; const float* lnb = INP(I_LNB) + (size_t)l * CCH;
    const int gw = F.bid * NWAVES + F.wave, NGW = F.G * NWAVES, lane = F.lane;
#define STOREV(it_) do { v4u w0, w1; \
        w0.x = pk2(v[0].x, v[0].y); w0.y = pk2(v[0].z, v[0].w); w0.z = pk2(v[1].x, v[1].y); w0.w = pk2(v[1].z, v[1].w); \
        w1.x = pk2(v[2].x, v[2].y); w1.y = pk2(v[2].z, v[2].w); w1.z = pk2(v[3].x, v[3].y); w1.w = pk2(v[3].z, v[3].w); \
        bf16* dst = MIXIN + (size_t)((it_) >> 1) * D + ((it_) & 1) * 1024 + 16 * lane; *(v4u*)dst = w0; *(v4u*)(dst + 8) = w1; } while (0)
    if ((gw & 1) == 0) {
        const int hd = lane >> 2;
        float ls[2][3]; v4u ob[2][6];
#define LOAD0(b, it_) do { const int m_ = (it_) >> 1; \
            ls[b][0] = LSE[(size_t)m_ * 16 + hd]; ls[b][1] = LSE[((size_t)MT + m_) * 16 + hd]; ls[b][2] = LSE[((size_t)2 * MT + m_) * 16 + hd]; \
            _Pragma("unroll") for (int q = 0; q < 3; ++q) { ob[b][2 * q] = *(const v4u*)(OB + ((size_t)q * MT + m_) * 1024 + 16 * lane); ob[b][2 * q + 1] = *(const v4u*)(OB + ((size_t)q * MT + m_) * 1024 + 16 * lane + 8); } } while (0)
#define MRG(A, B, C, k) (w0 * bflo(A[k]) + w1 * bflo(B[k]) + w2 * bflo(C[k])), (w0 * bfhi(A[k]) + w1 * bfhi(B[k]) + w2 * bfhi(C[k]))
#define COMP0(b, it_) do { f32x4 v[4]; \
            const float l0 = ls[b][0], l1 = ls[b][1], l2 = ls[b][2]; \
            const float mx = fmaxf(l0, fmaxf(l1, l2)); float w0 = __builtin_amdgcn_exp2f(l0 - mx), w1 = __builtin_amdgcn_exp2f(l1 - mx), w2 = __builtin_amdgcn_exp2f(l2 - mx); \
            const float inv = 1.0f / (w0 + w1 + w2); w0 *= inv; w1 *= inv; w2 *= inv; \
            const v4u a0 = ob[b][0], a1 = ob[b][1], b0 = ob[b][2], b1 = ob[b][3], c0 = ob[b][4], c1 = ob[b][5]; \
            v[0] = (f32x4){MRG(a0, b0, c0, 0), MRG(a0, b0, c0, 1)}; v[1] = (f32x4){MRG(a0, b0, c0, 2), MRG(a0, b0, c0, 3)}; \
            v[2] = (f32x4){MRG(a1, b1, c1, 0), MRG(a1, b1, c1, 1)}; v[3] = (f32x4){MRG(a1, b1, c1, 2), MRG(a1, b1, c1, 3)}; \
            float ss = 0.f; \
            _Pragma("unroll") for (int j = 0; j < 4; ++j) ss += (v[j].x * v[j].x + v[j].y * v[j].y) + (v[j].z * v[j].z + v[j].w * v[j].w); \
            const float r = 1.0f / sqrtf(wave_sum(ss) * (1.0f / AW) + EPS); \
            _Pragma("unroll") for (int j = 0; j < 4; ++j) v[j] = v[j] * r * *(const f32x4*)(g + 16 * lane + 4 * j); \
            STOREV(it_); } while (0)
        int it = gw;
        if (it < 2 * MT) LOAD0(0, it);
        if (it + NGW < 2 * MT) LOAD0(1, it + NGW);
        for (; it < 2 * MT; it += 2 * NGW) {
            __builtin_amdgcn_sched_barrier(0);
            COMP0(0, it);
            if (it + 2 * NGW < 2 * MT) LOAD0(0, it + 2 * NGW);
            __builtin_amdgcn_sched_barrier(0);
            if (it + NGW < 2 * MT) { COMP0(1, it + NGW); if (it + 3 * NGW < 2 * MT) LOAD0(1, it + 3 * NGW); }
        }
#undef LOAD0
#undef COMP0
#undef MRG
    } else {
        v4u yq[2][2];
#define LOAD1(b, it_) do { const int m_ = (it_) >> 1; yq[b][0] = *(const v4u*)(YP + (size_t)m_ * 1024 + 16 * lane); yq[b][1] = *(const v4u*)(YP + (size_t)m_ * 1024 + 16 * lane + 8); } while (0)
#define COMP1(b, it_) do { f32x4 v[4]; const v4u a0 = yq[b][0], a1 = yq[b][1]; \
            v[0] = (f32x4){bflo(a0.x), bfhi(a0.x), bflo(a0.y), bfhi(a0.y)}; v[1] = (f32x4){bflo(a0.z), bfhi(a0.z), bflo(a0.w), bfhi(a0.w)}; \
            v[2] = (f32x4){bflo(a1.x), bfhi(a1.x), bflo(a1.y), bfhi(a1.y)}; v[3] = (f32x4){bflo(a1.z), bfhi(a1.z), bflo(a1.w), bfhi(a1.w)}; \
            float s = 0.f; \
            _Pragma("unroll") for (int j = 0; j < 4; ++j) s += (v[j].x + v[j].y) + (v[j].z + v[j].w); \
            const float mean = wave_sum(s) * (1.0f / CCH); float q = 0.f; \
            _Pragma("unroll") for (int j = 0; j < 4; ++j) { v[j] = v[j] - mean; q += (v[j].x * v[j].x + v[j].y * v[j].y) + (v[j].z * v[j].z + v[j].w * v[j].w); } \
            const float rstd = 1.0f / sqrtf(wave_sum(q) * (1.0f / CCH) + EPS); \
            _Pragma("unroll") for (int j = 0; j < 4; ++j) { f32x4 y = v[j] * rstd * *(const f32x4*)(lng + 16 * lane + 4 * j) + *(const f32x4*)(lnb + 16 * lane + 4 * j); \
                y.x *= sigm(y.x); y.y *= sigm(y.y); y.z *= sigm(y.z); y.w *= sigm(y.w); v[j] = y; } \
            STOREV(it_); } while (0)
        int it = gw;
        if (it < 2 * MT) LOAD1(0, it);
        if (it + NGW < 2 * MT) LOAD1(1, it + NGW);
        for (; it < 2 * MT; it += 2 * NGW) {
            __builtin_amdgcn_sched_barrier(0);
            COMP1(0, it);
            if (it + 2 * NGW < 2 * MT) LOAD1(0, it + 2 * NGW);
            __builtin_amdgcn_sched_barrier(0);
            if (it + NGW < 2 * MT) { COMP1(1, it + NGW); if (it + 3 * NGW < 2 * MT) LOAD1(1, it + 3 * NGW); }
        }
#undef LOAD1
#undef COMP1
    }
#undef STOREV
}
template <int K>
__device__ __forceinline__ void skinny_phase(Frame& F, const bf16* A, const bf16* Bt, int N, float* part) {
    LAS float* red = (LAS float*)(F.lds + RING_OFF);
    constexpr int Kq = K / 4, Kw = Kq / 8, NS = Kw / 16;
    const int lane = launder(F.lane), r = lane & 31, h = lane >> 5, nsl = N / 32; const int tid = launder(F.tid);
    for (int it = F.bid; it < nsl * 4; it += F.G) {
        const int ns = it >> 2, kq = it & 3, k0 = kq * Kq + F.wave * Kw;
        f32x16 acc0, acc1;
#pragma unroll
        for (int i = 0; i < 16; ++i) { acc0[i] = 0.f; acc1[i] = 0.f; }
        const bf16* a0p = A + (size_t)r * K + k0 + 8 * h; const bf16* a1p = a0p + (size_t)32 * K; const bf16* bp = Bt + (size_t)(ns * 32 + r) * K + k0 + 8 * h;
        bf16x8 a0[NS], a1[NS], bv[NS];
#pragma unroll
        for (int s = 0; s < NS; ++s) { a0[s] = *(const bf16x8*)(a0p + 16 * s); a1[s] = *(const bf16x8*)(a1p + 16 * s); bv[s] = *(const bf16x8*)(bp + 16 * s); }
        __builtin_amdgcn_sched_barrier(0);
#pragma unroll
        for (int s = 0; s < NS; ++s) { acc0 = __builtin_amdgcn_mfma_f32_32x32x16_bf16(a0[s], bv[s], acc0, 0, 0, 0); acc1 = __builtin_amdgcn_mfma_f32_32x32x16_bf16(a1[s], bv[s], acc1, 0, 0, 0); }
        __syncthreads();
#pragma unroll
        for (int i = 0; i < 16; ++i) { const int row = (i & 3) + 8 * (i >> 2) + 4 * h; red[(F.wave * 64 + row) * 32 + r] = acc0[i]; red[(F.wave * 64 + 32 + row) * 32 + r] = acc1[i]; }
        __syncthreads();
        { const int o = tid * 4, row = o >> 5, col = o & 31; f32x4 s = (f32x4){0.f, 0.f, 0.f, 0.f};
#pragma unroll
          for (int wv = 0; wv < 8; ++wv) s += *(const LAS f32x4*)(red + (wv * 64 + row) * 32 + col);
          *(f32x4*)(part + ((size_t)kq * MS + row) * N + ns * 32 + col) = s; }
    }
    __syncthreads();
}

namespace pg8 {
struct GatedOrder : StaticOrder {
    const unsigned* ready;
    __device__ __forceinline__ void a_ready(const Unit& u) const {
        if (u.pm == 32) {
            if (threadIdx.x < 64) { unsigned sp = 0;
                while ((unsigned)__builtin_amdgcn_readfirstlane(__hip_atomic_load(ready, __ATOMIC_RELAXED, __HIP_MEMORY_SCOPE_AGENT)) < 16u) { __builtin_amdgcn_s_sleep(2); if (++sp > (1u << 24)) break; }
                __builtin_amdgcn_fence(__ATOMIC_ACQUIRE, "agent");
                asm volatile("s_waitcnt vmcnt(0)" ::: "memory"); }
            asm volatile("" ::: "memory"); __builtin_amdgcn_s_barrier(); asm volatile("" ::: "memory");
        }
    }
};
__device__ __forceinline__ f32x4 ubl(const u32x4 v) { return (f32x4){__builtin_bit_cast(float, v.x << 16), __builtin_bit_cast(float, v.x & 0xffff0000u), __builtin_bit_cast(float, v.y << 16), __builtin_bit_cast(float, v.y & 0xffff0000u)}; }
__device__ __forceinline__ f32x4 ubh(const u32x4 v) { return (f32x4){__builtin_bit_cast(float, v.z << 16), __builtin_bit_cast(float, v.z & 0xffff0000u), __builtin_bit_cast(float, v.w << 16), __builtin_bit_cast(float, v.w & 0xffff0000u)}; }
__device__ __forceinline__ void row_stats_a(const f32x4 (&v)[2][2][4][2], const Unit& u, int wr, int wc, int fr, int fq, PG8_LAS unsigned char* lds, int wid, int lane, unsigned* xs, unsigned* cnt) {
    PG8_LAS float* P = (PG8_LAS float*)lds;
    PG8_LAS float* S = (PG8_LAS float*)(lds + 4096);
#pragma unroll
    for (int ai = 0; ai < 2; ++ai)
#pragma unroll
        for (int m = 0; m < 4; ++m) { float s = 0.f;
#pragma unroll
            for (int bj = 0; bj < 2; ++bj)
#pragma unroll
                for (int n = 0; n < 2; ++n) { const f32x4 x = v[ai][bj][m][n]; s += (x[0] * x[0] + x[1] * x[1]) + (x[2] * x[2] + x[3] * x[3]); }
            s += __shfl_xor(s, 16); s += __shfl_xor(s, 32);
            if (fq == 0) P[(ai * HALF + wr * 64 + m * 16 + fr) * 4 + wc] = s; }
    asm volatile("s_waitcnt lgkmcnt(0)" ::: "memory"); __builtin_amdgcn_s_barrier(); asm volatile("" ::: "memory");
    const int row = wid * 32 + (lane & 31);
    if (lane < 32) { const f32x4 p = *(const PG8_LAS f32x4*)(P + row * 4);
        __hip_atomic_store(xs + (size_t)(u.pm * BM + row) * 8 + u.pn, __builtin_bit_cast(unsigned, (p[0] + p[1]) + (p[2] + p[3])), __ATOMIC_RELAXED, __HIP_MEMORY_SCOPE_AGENT); }
    asm volatile("s_waitcnt vmcnt(0)" ::: "memory");
    if (lane == 0) __hip_atomic_fetch_add(cnt + 64 * u.pm, 1u, __ATOMIC_RELAXED, __HIP_MEMORY_SCOPE_AGENT);
    if (wid == 0) { unsigned sp = 0;
        while ((unsigned)__builtin_amdgcn_readfirstlane(__hip_atomic_load(cnt + 64 * u.pm, __ATOMIC_RELAXED, __HIP_MEMORY_SCOPE_AGENT)) < 64u) { __builtin_amdgcn_s_sleep(2); if (++sp > (1u << 24)) break; }
        __builtin_amdgcn_fence(__ATOMIC_ACQUIRE, "agent"); }
    asm volatile("s_waitcnt vmcnt(0) lgkmcnt(0)" ::: "memory"); __builtin_amdgcn_s_barrier(); asm volatile("" ::: "memory");
}
__device__ __forceinline__ void row_stats_b(const Unit& u, PG8_LAS unsigned char* lds, int wid, int lane, unsigned* xs) {
    PG8_LAS float* S = (PG8_LAS float*)(lds + 4096);
    const int row = wid * 32 + (lane & 31);
    if (lane < 32) { const unsigned* slot = xs + (size_t)(u.pm * BM + row) * 8; float q = 0.f;
#pragma unroll
        for (int t = 0; t < 8; ++t) q += __builtin_bit_cast(float, __hip_atomic_load(slot + t, __ATOMIC_RELAXED, __HIP_MEMORY_SCOPE_AGENT));
        S[row] = 1.0f / sqrtf(q * (1.0f / 2048.0f) + 1e-6f); }
    asm volatile("s_waitcnt lgkmcnt(0)" ::: "memory"); __builtin_amdgcn_s_barrier(); asm volatile("" ::: "memory");
}
struct EpiResNorm {
    static constexpr bool PERM = true, AFTER_DRAIN = true;
    unsigned char* ws; float* out32;
    unsigned og, oa, ob, ocnt;
    __device__ __forceinline__ void fused(f32x4 (&acc)[2][2][4][2], const Unit& u, int wr, int wc, int fr, int fq, PG8_LAS unsigned char* lds, int wid, int lane) const {
        const PG8_LAS float* S = (const PG8_LAS float*)(lds + 4096);
        bf16_t* XR = (bf16_t*)(ws + WS_XRES); const bf16_t* MODT = (const bf16_t*)(ws + WS_MOD);
        unsigned* xs = (unsigned*)(ws + WS_O32); unsigned* cnt = (unsigned*)(ws + WS_CTL) + ocnt;
        const int c0 = u.pn * BM + wc * 32 + 8 * fq; const size_t vo = (size_t)(u.pm >> 3) * NMOD + c0;
        u32x4 g1[2];
#pragma unroll
        for (int bj = 0; bj < 2; ++bj) g1[bj] = *(const u32x4*)(MODT + og + vo + bj * HALF);
        u32x4 pre[4][2];
#pragma unroll
        for (int m = 0; m < 4; ++m)
#pragma unroll
            for (int bj = 0; bj < 2; ++bj) pre[m][bj] = *(const u32x4*)(XR + (size_t)(u.pm * BM + wr * 64 + m * 16 + fr) * D + c0 + bj * HALF);
        row_stats_a(acc, u, wr, wc, fr, fq, lds, wid, lane, xs, cnt);
        u32x4 pre1[4][2];
#pragma unroll
        for (int m = 0; m < 4; ++m)
#pragma unroll
            for (int bj = 0; bj < 2; ++bj) pre1[m][bj] = *(const u32x4*)(XR + (size_t)(u.pm * BM + HALF + wr * 64 + m * 16 + fr) * D + c0 + bj * HALF);
        row_stats_b(u, lds, wid, lane, xs);
#pragma unroll
        for (int ai = 0; ai < 2; ++ai)
#pragma unroll
            for (int m = 0; m < 4; ++m) { const int r = ai * HALF + wr * 64 + m * 16 + fr; const float rs = S[r];
#pragma unroll
                for (int bj = 0; bj < 2; ++bj) { const u32x4 xq = ai == 0 ? pre[m][bj] : pre1[m][bj];
                    acc[ai][bj][m][0] = ubl(xq) + ubl(g1[bj]) * (acc[ai][bj][m][0] * rs); acc[ai][bj][m][1] = ubh(xq) + ubh(g1[bj]) * (acc[ai][bj][m][1] * rs); }
                asm volatile("" : "+v"(acc[ai][0][m][0]), "+v"(acc[ai][0][m][1]), "+v"(acc[ai][1][m][0]), "+v"(acc[ai][1][m][1])); }
        if (out32) {
#pragma unroll
            for (int ai = 0; ai < 2; ++ai)
#pragma unroll
                for (int m = 0; m < 4; ++m) { float* o = out32 + (size_t)(u.pm * BM + ai * HALF + wr * 64 + m * 16 + fr) * D + c0;
#pragma unroll
                    for (int bj = 0; bj < 2; ++bj) { *(f32x4*)(o + bj * HALF) = acc[ai][bj][m][0]; *(f32x4*)(o + bj * HALF + 4) = acc[ai][bj][m][1]; } }
        } else {
            bf16_t* Hh = (bf16_t*)(ws + WS_H);
            u32x4 g2[2], g3[2];
#pragma unroll
            for (int bj = 0; bj < 2; ++bj) { g2[bj] = *(const u32x4*)(MODT + oa + vo + bj * HALF); g3[bj] = *(const u32x4*)(MODT + ob + vo + bj * HALF); }
            row_stats_a(acc, u, wr, wc, fr, fq, lds, wid, lane, xs + 8192 * 8, cnt + 2048); row_stats_b(u, lds, wid, lane, xs + 8192 * 8);
#pragma unroll
            for (int ai = 0; ai < 2; ++ai)
#pragma unroll
                for (int m = 0; m < 4; ++m) { const int r = ai * HALF + wr * 64 + m * 16 + fr; const float rs = S[r]; const size_t off = (size_t)(u.pm * BM + r) * D + c0;
#pragma unroll
                    for (int bj = 0; bj < 2; ++bj) { const f32x4 x0 = acc[ai][bj][m][0], x1 = acc[ai][bj][m][1];
                        *(u32x4*)(XR + off + bj * HALF) = pack8(x0, x1);
                        *(u32x4*)(Hh + off + bj * HALF) = pack8(x0 * rs * ubl(g2[bj]) + ubl(g3[bj]), x1 * rs * ubh(g2[bj]) + ubh(g3[bj])); } }
        }
    }
};
}

#ifndef N_LAUNCH_MODE
#define N_LAUNCH_MODE 1
#endif
struct Args { const float* in[N_IN]; float* out; unsigned char* ws; int ph_lo, ph_hi; };
constexpr int PH_PRO = 3, PH_PER_LAYER = 8, PH_TOTAL = PH_PRO + DEPTH * PH_PER_LAYER;
__global__ void __launch_bounds__(NWAVES * 64, 2) fwd(Args args) {
    extern __shared__ __attribute__((aligned(16))) unsigned char lds[];
    Frame F;
    F.lds = (LAS unsigned char*)lds;
    F.MISC = (volatile LAS unsigned*)(F.lds + MISC_OFF);
    F.tid = threadIdx.x; F.lane = F.tid & 63; F.wave = __builtin_amdgcn_readfirstlane(F.tid >> 6);
    F.G = gridDim.x; F.bid = blockIdx.x;
    F.ws = args.ws; F.out = args.out; F.ctl = (gu32*)(args.ws + WS_CTL);
    for (int u = F.tid; u < (LDS_BYTES - LDSCTL_OFF) / 4; u += NWAVES * 64) ((LAS unsigned*)(F.lds + LDSCTL_OFF))[u] = 0u;
    __syncthreads();
    if (F.tid == 0) {
#pragma unroll
        for (int i = 0; i < N_IN; ++i) ((LAS unsigned long long*)(F.lds + LDSCTL_OFF))[i] = (unsigned long long)args.in[i];
    }
    __syncthreads();
#if N_LAUNCH_MODE == 1
    constexpr int lo = 0, hi = PH_TOTAL; constexpr bool multi = true;
#else
    const int lo = args.ph_lo, hi = args.ph_hi;
    const bool multi = (hi - lo) > 1;
#endif
    XcdBarrier bar; bar.bar = (unsigned*)(F.ctl + CW_BAR); bar.x = 0; bar.st = nullptr;
    if (multi) bar = xcd_barrier_post((unsigned*)(F.ctl + CW_BAR), F.MISC + 8);
#define RELAUNDER() do { F.lane = lane_id_now(); F.tid = F.wave * 64 + F.lane; { unsigned long long w_ = (unsigned long long)F.ws, o_ = (unsigned long long)F.out; asm volatile("" : "+s"(w_), "+s"(o_)); F.ws = (unsigned char*)(GAS unsigned char*)w_; F.out = (float*)(GAS float*)o_; } } while (0)
#define RELAUNDER_V() (F.wave * 64 + lane_id_now())
#define IN(k) (lo <= (k) && (k) < hi)
#define SEAM(k) do { if (IN(k) && IN((k) + 1)) { xcd_barrier(bar); if (PROBE_DUP == 200) xcd_barrier(bar); } } while (0)

#define Hb ((bf16*)(F.ws + WS_H))
#define SIGW(k) ((unsigned*)(F.ws + WS_CTL) + 131072 + 64 * (k))
#define MIXIN ((bf16*)(F.ws + WS_MIXIN))
#define MIX ((bf16*)(F.ws + WS_MIX))
#define FACT ((bf16*)(F.ws + WS_FACT))
#define Fb ((bf16*)(F.ws + WS_F))
#define SKP ((float*)(F.ws + WS_SKP))
#define MOD ((const bf16*)(F.ws + WS_MOD))

#ifndef PHMASK
#define PHMASK 0xFFFF
#endif
#define PM(k) ((PHMASK >> (k)) & 1)
#ifndef PROBE_DUP
#define PROBE_DUP (-1)
#endif
#define REP(k) for (int rep_ = 0; rep_ < ((PROBE_DUP == (k)) ? 2 : 1); ++rep_)
    if (PM(0) && IN(0)) { REP(0) { REP(100) { RELAUNDER(); p0_transposes(F); } REP(101) { RELAUNDER(); p0_mod_partials(F); } REP(102) { RELAUNDER(); if (F.G != 256) p0_cache_copy(F); } } } SEAM(0);
    if (PM(1) && IN(1)) { RELAUNDER(); p0_mod_reduce(F); } SEAM(1);
    if (PM(2) && IN(2)) {
        RELAUNDER();
        resnorm_rows<false, true>(F, INP(I_XP), INP(I_XS), nullptr, nullptr, nullptr, nullptr, nullptr, MOD + 1 * D, MOD + 0 * D, Hb, SIGW(8));
    } SEAM(2);

    for (int l = 0; l < DEPTH; ++l) {
        const int pb = PH_PRO + l * PH_PER_LAYER;
#define modl (MOD + (size_t)l * 12 * NMOD)
        if (PM(3) && IN(pb + 0)) REP(3) {
            pg8::Gemm g{Hb, (const bf16*)(F.ws + WS_WIN + l * SZ_WIN), MPAD, NIN, D}; pg8::GatedOrder S; S.init(MPAD, NIN, F.G, F.bid); S.ready = SIGW(l == 0 ? 8 : (l - 1) * 2 + 1);
            pg8::EpiIn E{(bf16*)(F.ws + WS_Q), (size_t)(WS_K - WS_Q) / 2, (bf16*)(F.ws + WS_U),
                         F.out + O_KP + (size_t)l * MP * 1024, (size_t)(O_VP - O_KP), F.out + O_KS + (size_t)l * 8 * WBUF * 1024, (size_t)(O_VS - O_KS), QSCALE};
            pg8::gemm_phase<pg8::EpiIn, pg8::GatedOrder, true, true>(F.lds + RING_OFF, g, S, E, (RELAUNDER_V()));
            if (F.G == 256 && F.bid >= 148) { RELAUNDER(); tail_copy(F, l, F.bid - 148); }
        } SEAM(pb + 0);
        if (PM(4) && IN(pb + 1)) REP(4) {
#ifndef NO_ATTN
            RELAUNDER();
            REP(40) { RELAUNDER(); attn_mfma_phase(F); }
            RELAUNDER();
            REP(41) attn_sample_phase(F, l);
#endif
#ifndef NO_CONV
            RELAUNDER();
            REP(42) conv_phase(F, l);
#endif
        } SEAM(pb + 1);
        if (PM(5) && IN(pb + 2)) REP(5) { RELAUNDER(); onorm_phase(F, l); } SEAM(pb + 2);
        if (PM(6) && IN(pb + 3)) REP(6) {
            pg8::Gemm g{MIXIN, (const bf16*)(F.ws + WS_WOUT + l * SZ_WOUT), MP, D, D}; pg8::StaticOrder S; S.init(MP, D, F.G, F.bid);
            pg8::EpiResNorm E{F.ws, nullptr, (unsigned)(l * 12 * NMOD + 2 * D), (unsigned)(l * 12 * NMOD + 4 * D), (unsigned)(l * 12 * NMOD + 3 * D), (unsigned)(65536 + (l * 2 + 0) * 4096)};
            pg8::gemm_phase<pg8::EpiResNorm, pg8::StaticOrder, true, true>(F.lds + RING_OFF, g, S, E, (RELAUNDER_V()));
#ifndef NO_SKINNY
            RELAUNDER();
            skinny_phase<D>(F, MIXIN + (size_t)MP * D, (const bf16*)(F.ws + WS_WOUT + l * SZ_WOUT), D, SKP);
#endif
        } SEAM(pb + 3);
        if (PM(7) && IN(pb + 4)) {
            RELAUNDER();
            resnorm_rows<true, false, false>(F, nullptr, nullptr, nullptr, nullptr, MIX, SKP, modl + 2 * D, modl + 4 * D, modl + 3 * D, Hb, SIGW(l * 2 + 0));
        }
        if (PM(8) && IN(pb + 5)) REP(8) {
            pg8::Gemm g{Hb, (const bf16*)(F.ws + WS_WGU + l * SZ_WGU), MPAD, NGU, D}; pg8::GatedOrder S; S.init(MPAD, NGU, F.G, F.bid); S.ready = SIGW(l * 2 + 0);
            pg8::EpiSwiGLU E{FACT, DFF};
            pg8::gemm_phase<pg8::EpiSwiGLU, pg8::GatedOrder, true, true>(F.lds + RING_OFF, g, S, E, (RELAUNDER_V()));
            if (F.G == 256 && F.bid >= 172) { RELAUNDER(); tail_copy(F, l, 108 + F.bid - 172); }
        } SEAM(pb + 5);
        if (PM(9) && IN(pb + 6)) REP(9) {
            pg8::Gemm g{FACT, (const bf16*)(F.ws + WS_WDN + l * SZ_WDN), MP, D, DFF}; pg8::StaticOrder S; S.init(MP, D, F.G, F.bid);
            const int ln = (l == DEPTH - 1) ? l : l + 1;
            pg8::EpiResNorm E{F.ws, (l == DEPTH - 1) ? F.out + O_YP : nullptr, (unsigned)(l * 12 * NMOD + 5 * D), (unsigned)(ln * 12 * NMOD + 1 * D), (unsigned)(ln * 12 * NMOD + 0 * D), (unsigned)(65536 + (l * 2 + 1) * 4096)};
            pg8::gemm_phase<pg8::EpiResNorm, pg8::StaticOrder, true, true>(F.lds + RING_OFF, g, S, E, (RELAUNDER_V()));
#ifndef NO_SKINNY
            RELAUNDER();
            skinny_phase<DFF>(F, FACT + (size_t)MP * DFF, (const bf16*)(F.ws + WS_WDN + l * SZ_WDN), D, SKP);
#endif
        } SEAM(pb + 6);
        if (PM(10) && IN(pb + 7)) {
            const bool last = (l == DEPTH - 1);
            float* op = last ? F.out + O_YP : nullptr; float* os = last ? F.out + O_YS : nullptr;
            const bf16* modn = MOD + (size_t)(last ? l : l + 1) * 12 * NMOD;
            RELAUNDER();
            resnorm_rows<true, false, false>(F, nullptr, nullptr, op, os, Fb, SKP, modl + 5 * D, modn + 1 * D, modn + 0 * D, last ? nullptr : Hb, SIGW(l * 2 + 1));
        }
    }
#undef IN
#undef SEAM
#undef Hb
#undef MIXIN
#undef MIX
#undef FACT
#undef Fb
#undef SKP
#undef MOD
#undef modl
}

extern "C" void kernel_launch(void* const* d_in, const int* in_sizes, int n_in, void* d_out, int out_size, void* d_ws, size_t ws_size, hipStream_t stream) {
    static int grid = 0;
    if (grid == 0) {
        if (n_in != N_IN || (size_t)out_size != O_END || ws_size < WS_END) { fprintf(stderr, "kernel_launch: unexpected shapes: n_in %d out %d ws %zu (need %zu)\n", n_in, out_size, ws_size, (size_t)WS_END); grid = -1; return; }
        int dev = 0, cus = 0, per_cu = 0;
        if (hipGetDevice(&dev) != hipSuccess || hipDeviceGetAttribute(&cus, hipDeviceAttributeMultiprocessorCount, dev) != hipSuccess) { grid = -1; return; }
        if (hipFuncSetAttribute((const void*)fwd, hipFuncAttributeMaxDynamicSharedMemorySize, LDS_BYTES) != hipSuccess) { fprintf(stderr, "kernel_launch: hipFuncSetAttribute failed\n"); grid = -1; return; }
        if (hipOccupancyMaxActiveBlocksPerMultiprocessor(&per_cu, (const void*)fwd, NWAVES * 64, LDS_BYTES) != hipSuccess || per_cu < 1) fprintf(stderr, "kernel_launch: occupancy query says %d\n", per_cu);
        (void)hipGetLastError();
        if (cus != 256) { fprintf(stderr, "kernel_launch: built for 256 CUs (one 256x256 unit per workgroup in the fused-norm GEMM phases), device has %d\n", cus); grid = -1; return; }
        grid = cus;
    }
    if (grid < 0) return;
    if (hipMemsetAsync((char*)d_ws + WS_CTL, 0, CTL_ZERO_BYTES, stream) != hipSuccess) return;
    Args a{};
    for (int i = 0; i < N_IN; ++i) a.in[i] = (const float*)d_in[i];
    a.out = (float*)d_out; a.ws = (unsigned char*)d_ws;
    if (N_LAUNCH_MODE == 1) { a.ph_lo = 0; a.ph_hi = PH_TOTAL; hipLaunchKernelGGL(fwd, dim3(grid), dim3(NWAVES * 64), LDS_BYTES, stream, a); }
    else for (int p = 0; p < PH_TOTAL; ++p) { a.ph_lo = p; a.ph_hi = p + 1; hipLaunchKernelGGL(fwd, dim3(grid), dim3(NWAVES * 64), LDS_BYTES, stream, a); }
}
```

```cpp
#define PROBE_DUP -1
#include <hip/hip_runtime.h>
#include <cstdio>
#include <cstdint>
#include <cmath>
namespace pg8 {
#define PG8_LAS __attribute__((address_space(3)))
typedef unsigned short bf16_t;
typedef short bf16x8 __attribute__((ext_vector_type(8)));
typedef float f32x4 __attribute__((ext_vector_type(4)));
typedef unsigned u32x4 __attribute__((ext_vector_type(4)));
constexpr int BM = 256, BK = 64, HALF = 128, HTB = HALF * BK * 2  , STAGE_BYTES = 8 * HTB, NXCD = 8, WGM = 8;

__host__ __device__ __forceinline__ int lds_byte(int r, int c) { const int st = (r >> 4) * 2 + (c >> 5), rr = r & 15, cc = c & 31, ob = rr * 64 + cc * 2; return st * 1024 + (ob ^ (((ob >> 9) & 1) << 5)); }
__host__ __device__ __forceinline__ void stage_rc(int b, int& R, int& C) { const int st = b / 1024, sb = b % 1024, swz = sb ^ (((sb >> 9) & 1) << 5); R = (st >> 1) * 16 + swz / 64; C = (st & 1) * 32 + (swz % 64) / 2; }
__host__ __device__ __forceinline__ int perm32(int rho) { const int n = rho >> 4, i = rho & 15; return 8 * (i >> 2) + 4 * n + (i & 3); }

struct Unit { int pm, pn; };
struct Gemm { const bf16_t* A; const bf16_t* Bt; int M, N, K; };

struct StaticOrder {
    int nM, nN, nwg, G, c;
    __host__ __device__ void init(int M, int N, int G_, int c_) { nM = M / BM; nN = N / BM; nwg = nM * nN; G = G_; c = c_; }
    __host__ __device__ bool next(int i, Unit& u) const {
        const long L = (long)i * G + c; if (L >= nwg) return false;
        int wgid = (int)L; { const int q = nwg / NXCD, r = nwg % NXCD, xcd = wgid % NXCD, off = wgid / NXCD; wgid = (xcd < r ? xcd * (q + 1) : r * (q + 1) + (xcd - r) * q) + off; }
        const int nig = WGM * nN, gid = wgid / nig, fm = gid * WGM, gsz = (nM - fm) < WGM ? (nM - fm) : WGM;
        u.pm = fm + ((wgid % nig) % gsz); u.pn = (wgid % nig) / gsz; return true;
    }
    __device__ __forceinline__ void a_ready(const Unit&) const {}
    __device__ __forceinline__ void done(const Unit&) const {}
};

__device__ __forceinline__ unsigned cvt_pk_bf16(float lo, float hi) { unsigned r; asm volatile("v_cvt_pk_bf16_f32 %0, %1, %2" : "=v"(r) : "v"(lo), "v"(hi)); return r; }
constexpr int ROWS_P = 8192, ROWS_T = 8256;
__device__ __forceinline__ float sigmoidf_fast(float x) { return __builtin_amdgcn_rcpf(1.0f + __builtin_amdgcn_exp2f(-1.4426950408889634f * x)); }
__device__ __forceinline__ u32x4 pack8(const f32x4 v0, const f32x4 v1) { u32x4 w; w.x = cvt_pk_bf16(v0[0], v0[1]); w.y = cvt_pk_bf16(v0[2], v0[3]); w.z = cvt_pk_bf16(v1[0], v1[1]); w.w = cvt_pk_bf16(v1[2], v1[3]); return w; }

struct EpiIn {
    static constexpr bool PERM = true, AFTER_DRAIN = false;
    bf16_t *QKV; size_t qkv_stride;
    bf16_t *Ub; float *kvp; size_t kvp_stride;
    float *kvs; size_t kvs_stride; float qscale;
    __device__ __forceinline__ void operator()(const f32x4 (&acc)[2][2][4][2], const Unit& u, int wr, int wc, int fr, int fq) const {
        const int rbase = u.pm * BM + wr * 64 + fr;
        if (u.pn < 12) {
            const int t = u.pn >> 2, colt = (u.pn & 3) * 256 + wc * 32 + 8 * fq;
            bf16_t* dst = QKV + (size_t)t * qkv_stride; const float sc = t == 0 ? qscale : 1.f;
            float* fo_p = kvp + (size_t)(t == 2 ? 1 : 0) * kvp_stride; float* fo_s = kvs + (size_t)(t == 2 ? 1 : 0) * kvs_stride;
#pragma unroll
            for (int ai = 0; ai < 2; ++ai)
#pragma unroll
                for (int m = 0; m < 4; ++m) { const int row = rbase + ai * HALF + m * 16;
                    if (row < ROWS_T) {
                        float* fo = row < ROWS_P ? fo_p + (size_t)row * 1024 : fo_s + ((size_t)((row - ROWS_P) >> 3) * 2048 + 2040 + ((row - ROWS_P) & 7)) * 1024;
#pragma unroll
                        for (int bj = 0; bj < 2; ++bj) { const f32x4 v0 = acc[ai][bj][m][0] * sc, v1 = acc[ai][bj][m][1] * sc; const int col = colt + bj * HALF;
                            *(u32x4*)(dst + (size_t)row * 1024 + col) = pack8(v0, v1);
                            if (t != 0) { *(f32x4*)(fo + col) = v0; *(f32x4*)(fo + col + 4) = v1; } } } }
        } else {
            const int ch = (u.pn - 12) * 128 + wc * 32 + 8 * fq;
#pragma unroll
            for (int ai = 0; ai < 2; ++ai)
#pragma unroll
                for (int m = 0; m < 4; ++m) { const int row = rbase + ai * HALF + m * 16;
                    if (row < ROWS_T) { f32x4 o[2];
#pragma unroll
                        for (int n = 0; n < 2; ++n) { const f32x4 a = acc[ai][0][m][n], g = acc[ai][1][m][n];
#pragma unroll
                            for (int e = 0; e < 4; ++e) o[n][e] = a[e] * sigmoidf_fast(g[e]); }
                        *(u32x4*)(Ub + (size_t)row * 1024 + ch) = pack8(o[0], o[1]); } }
        }
    }
};
struct EpiPlain {
    static constexpr bool PERM = true, AFTER_DRAIN = false;
    bf16_t* O; int ldc;
    __device__ __forceinline__ void operator()(const f32x4 (&acc)[2][2][4][2], const Unit& u, int wr, int wc, int fr, int fq) const {
        const int rbase = u.pm * BM + wr * 64 + fr, col0 = u.pn * BM + wc * 32 + 8 * fq;
#pragma unroll
        for (int ai = 0; ai < 2; ++ai)
#pragma unroll
            for (int m = 0; m < 4; ++m) { const int row = rbase + ai * HALF + m * 16;
                if (row < ROWS_T) {
#pragma unroll
                    for (int bj = 0; bj < 2; ++bj) *(u32x4*)(O + (size_t)row * ldc + col0 + bj * HALF) = pack8(acc[ai][bj][m][0], acc[ai][bj][m][1]); } }
    }
};
struct EpiSwiGLU {
    static constexpr bool PERM = true, AFTER_DRAIN = false;
    bf16_t* O; int ldc;
    __device__ __forceinline__ void operator()(const f32x4 (&acc)[2][2][4][2], const Unit& u, int wr, int wc, int fr, int fq) const {
        const int rbase = u.pm * BM + wr * 64 + fr, col0 = u.pn * 128 + wc * 32 + 8 * fq;
#if defined(PROBE_DUP) && PROBE_DUP == 80
        for (int rep_ = 0; rep_ < 2; ++rep_) { asm volatile("" ::: "memory");
#endif
#pragma unroll
        for (int ai = 0; ai < 2; ++ai)
#pragma unroll
            for (int m = 0; m < 4; ++m) { const int row = rbase + ai * HALF + m * 16;
                if (row < ROWS_T) { f32x4 o[2];
#pragma unroll
                    for (int n = 0; n < 2; ++n) { const f32x4 g = acc[ai][0][m][n], up = acc[ai][1][m][n];
#pragma unroll
                        for (int e = 0; e < 4; ++e) o[n][e] = g[e] * sigmoidf_fast(g[e]) * up[e]; }
                    *(u32x4*)(O + (size_t)row * ldc + col0) = pack8(o[0], o[1]); } }
#if defined(PROBE_DUP) && PROBE_DUP == 80
        }
#endif
    }
};
template <class Epi, class Sched, bool ALIGN_EPI = false, bool SP2 = false>
__device__ __forceinline__ void gemm_phase(PG8_LAS unsigned char* lds, const Gemm g, const Sched& S, const Epi& E, int tid_in) {
    int tid_ = tid_in; asm volatile("" : "+v"(tid_));
    const int tid = tid_, wid = __builtin_amdgcn_readfirstlane(tid >> 6), lane = tid & 63, wr = wid >> 2, wc = wid & 3, fr = lane & 15, fq = lane >> 4;
    const int K = g.K, nt = K / BK;
    unsigned voffA[2], voffB[2];
#pragma unroll
    for (int i = 0; i < 2; ++i) { int R, C; stage_rc(tid * 16 + i * 8192, R, C); const int Rb = Epi::PERM ? ((R & ~31) + perm32(R & 31)) : R;
        voffA[i] = (unsigned)(R * K + C) * 2u; voffB[i] = (unsigned)(Rb * K + C) * 2u; }
    const size_t kstep = (size_t)(BK * 2);
    const size_t hstep = (size_t)HALF * K * 2;
    const size_t tstep = 2 * hstep;
    const unsigned ldsw = (unsigned)wid * 1024u;
    const int aoff = lds_byte(wr * 64 + fr, fq * 8), boff = lds_byte(wc * 32 + fr, fq * 8);
#define PG8_SA(b, h) (((b) * 2 + (h)) * HTB)
#define PG8_SB(b, h) ((4 + (b) * 2 + (h)) * HTB)
#define PG8_STAGE(bufoff, gbase, voff) do { _Pragma("unroll") for (int _i = 0; _i < 2; ++_i) \
        __builtin_amdgcn_global_load_lds((const unsigned*)((const char*)(gbase) + (voff)[_i]), (PG8_LAS unsigned*)(lds + (bufoff) + ldsw + _i * 8192), 16, 0, 0); } while (0)
#define PG8_LDA(dst, b, h) do { _Pragma("unroll") for (int m = 0; m < 4; ++m) _Pragma("unroll") for (int k = 0; k < 2; ++k) dst[m][k] = *(const PG8_LAS bf16x8*)(lds + PG8_SA(b, h) + aoff + m * 2048 + k * 1024); } while (0)
#define PG8_LDB(dst, b, h) do { _Pragma("unroll") for (int n = 0; n < 2; ++n) _Pragma("unroll") for (int k = 0; k < 2; ++k) dst[n][k] = *(const PG8_LAS bf16x8*)(lds + PG8_SB(b, h) + boff + n * 2048 + k * 1024); } while (0)
#define PG8_MMA(ai, bj, At, Bt) do { __builtin_amdgcn_s_setprio(1); _Pragma("unroll") for (int m = 0; m < 4; ++m) _Pragma("unroll") for (int n = 0; n < 2; ++n) _Pragma("unroll") for (int k = 0; k < 2; ++k) \
        acc[ai][bj][m][n] = __builtin_amdgcn_mfma_f32_16x16x32_bf16(Bt[n][k], At[m][k], acc[ai][bj][m][n], 0, 0, 0); __builtin_amdgcn_s_setprio(0); } while (0)
#define PG8_WAIT_V(n) asm volatile("s_waitcnt vmcnt(" #n ")" ::: "memory")
#define PG8_WAIT_L(n) asm volatile("s_waitcnt lgkmcnt(" #n ")" ::: "memory")
#define PG8_BAR __builtin_amdgcn_s_barrier()
#define PG8_SCHED __builtin_amdgcn_sched_barrier(0)
    Unit cur, nxt; int ui = 0;
    if (!S.next(0, cur)) return;
    f32x4 acc[2][2][4][2];
#pragma unroll
    for (int a = 0; a < 2; ++a)
#pragma unroll
        for (int b = 0; b < 2; ++b)
#pragma unroll
            for (int m = 0; m < 4; ++m)
#pragma unroll
                for (int n = 0; n < 2; ++n) acc[a][b][m][n] = (f32x4){0.f, 0.f, 0.f, 0.f};
    bf16x8 At[4][2], B0[2][2], B1[2][2];
    const char* cA = (const char*)g.A + (size_t)cur.pm * tstep; const char* cB = (const char*)g.Bt + (size_t)cur.pn * tstep;
    S.a_ready(cur);
    if constexpr (SP2) {
        PG8_STAGE(PG8_SB(0, 0), cB, voffB); PG8_STAGE(PG8_SB(0, 1), cB + hstep, voffB); PG8_STAGE(PG8_SA(0, 0), cA, voffA); PG8_STAGE(PG8_SA(0, 1), cA + hstep, voffA);
        if (wr == 1) PG8_BAR;
        PG8_WAIT_V(2); PG8_BAR;
        PG8_STAGE(PG8_SB(1, 0), cB + kstep, voffB); PG8_STAGE(PG8_SA(1, 0), cA + kstep, voffA); PG8_STAGE(PG8_SB(1, 1), cB + hstep + kstep, voffB);
        PG8_WAIT_V(6); PG8_BAR;
    } else {
        PG8_STAGE(PG8_SB(0, 0), cB, voffB); PG8_STAGE(PG8_SA(0, 0), cA, voffA); PG8_STAGE(PG8_SB(0, 1), cB + hstep, voffB); PG8_STAGE(PG8_SA(0, 1), cA + hstep, voffA);
        if (wr == 1) PG8_BAR;
        PG8_WAIT_V(4); PG8_BAR;
        PG8_STAGE(PG8_SB(1, 0), cB + kstep, voffB); PG8_STAGE(PG8_SA(1, 0), cA + kstep, voffA); PG8_STAGE(PG8_SB(1, 1), cB + hstep + kstep, voffB);
        PG8_WAIT_V(6); PG8_BAR;
    }
    for (;;) {
        const bool has_next = S.next(ui + 1, nxt);
        const char* nA = has_next ? (const char*)g.A + (size_t)nxt.pm * tstep : cA; const char* nB = has_next ? (const char*)g.Bt + (size_t)nxt.pn * tstep : cB;
        for (int t = 0; t < nt; t += 2) {
            const bool last = (t == nt - 2);
            const char* a1 = cA + (size_t)(t + 1) * kstep;
            const char* a2 = last ? nA : cA + (size_t)(t + 2) * kstep; const char* b2 = last ? nB : cB + (size_t)(t + 2) * kstep;
            const char* a3 = a2 + kstep; const char* b3 = b2 + kstep;
            if (last && has_next) S.a_ready(nxt);
            if constexpr (SP2) {
            PG8_LDB(B0, 0, 0); PG8_LDB(B1, 0, 1); PG8_SCHED; PG8_LDA(At, 0, 0); PG8_STAGE(PG8_SA(1, 1), a1 + hstep, voffA);
            PG8_WAIT_V(8); PG8_WAIT_L(0); PG8_BAR; PG8_MMA(0, 0, At, B0); PG8_MMA(0, 1, At, B1); PG8_BAR; PG8_SCHED;
            PG8_LDA(At, 0, 1); PG8_STAGE(PG8_SB(0, 0), b2, voffB); PG8_STAGE(PG8_SB(0, 1), b2 + hstep, voffB); PG8_STAGE(PG8_SA(0, 0), a2, voffA);
            PG8_WAIT_V(8); PG8_WAIT_L(0); PG8_BAR; PG8_MMA(1, 0, At, B0); PG8_MMA(1, 1, At, B1); PG8_BAR; PG8_SCHED;
            PG8_LDB(B0, 1, 0); PG8_LDB(B1, 1, 1); PG8_SCHED; PG8_LDA(At, 1, 0); PG8_STAGE(PG8_SA(0, 1), a2 + hstep, voffA);
            PG8_WAIT_V(8); PG8_WAIT_L(0); PG8_BAR; PG8_MMA(0, 0, At, B0); PG8_MMA(0, 1, At, B1); PG8_BAR; PG8_SCHED;
            PG8_LDA(At, 1, 1); PG8_STAGE(PG8_SB(1, 0), b3, voffB); PG8_STAGE(PG8_SB(1, 1), b3 + hstep, voffB); PG8_STAGE(PG8_SA(1, 0), a3, voffA);
            PG8_WAIT_V(8); PG8_WAIT_L(0); PG8_BAR; PG8_MMA(1, 0, At, B0); PG8_MMA(1, 1, At, B1); PG8_BAR; PG8_SCHED;
            } else {
            PG8_LDB(B0, 0, 0); PG8_SCHED; PG8_LDA(At, 0, 0); PG8_STAGE(PG8_SA(1, 1), a1 + hstep, voffA);
            PG8_WAIT_L(8); PG8_BAR; PG8_WAIT_L(0); PG8_MMA(0, 0, At, B0); PG8_BAR; PG8_SCHED;
            PG8_LDB(B1, 0, 1); PG8_STAGE(PG8_SB(0, 0), b2, voffB);
            PG8_BAR; PG8_WAIT_L(0); PG8_MMA(0, 1, At, B1); PG8_BAR;
            PG8_LDA(At, 0, 1); PG8_STAGE(PG8_SA(0, 0), a2, voffA);
            PG8_BAR; PG8_WAIT_L(0); PG8_MMA(1, 0, At, B0); PG8_BAR; PG8_SCHED;
            PG8_STAGE(PG8_SB(0, 1), b2 + hstep, voffB);
            PG8_WAIT_V(6); PG8_BAR; PG8_MMA(1, 1, At, B1); PG8_BAR;
            PG8_LDB(B0, 1, 0); PG8_SCHED; PG8_LDA(At, 1, 0); PG8_STAGE(PG8_SA(0, 1), a2 + hstep, voffA);
            PG8_WAIT_L(8); PG8_BAR; PG8_WAIT_L(0); PG8_MMA(0, 0, At, B0); PG8_BAR; PG8_SCHED;
            PG8_LDB(B1, 1, 1); PG8_STAGE(PG8_SB(1, 0), b3, voffB);
            PG8_BAR; PG8_WAIT_L(0); PG8_MMA(0, 1, At, B1); PG8_BAR;
            PG8_LDA(At, 1, 1); PG8_STAGE(PG8_SA(1, 0), a3, voffA);
            PG8_BAR; PG8_WAIT_L(0); PG8_MMA(1, 0, At, B0); PG8_BAR; PG8_SCHED;
            PG8_STAGE(PG8_SB(1, 1), b3 + hstep, voffB);
            PG8_WAIT_V(6); PG8_BAR; PG8_MMA(1, 1, At, B1); PG8_BAR;
            }
        }
        if constexpr (ALIGN_EPI) { if (wr == 0) PG8_BAR; }
        if constexpr (!Epi::AFTER_DRAIN) { E(acc, cur, wr, wc, fr, fq); S.done(cur); }
        if (!has_next) break;
#pragma unroll
        for (int a = 0; a < 2; ++a)
#pragma unroll
            for (int b = 0; b < 2; ++b)
#pragma unroll
                for (int m = 0; m < 4; ++m)
#pragma unroll
                    for (int n = 0; n < 2; ++n) acc[a][b][m][n] = (f32x4){0.f, 0.f, 0.f, 0.f};
        cur = nxt; cA = nA; cB = nB; ++ui;
        if constexpr (ALIGN_EPI) { if (wr == 1) PG8_BAR; }
    }
    PG8_WAIT_V(0);
    if constexpr (!ALIGN_EPI) { if (wr == 0) PG8_BAR; }
    PG8_BAR;
    if constexpr (Epi::AFTER_DRAIN) { E.fused(acc, cur, wr, wc, fr, fq, lds, wid, lane); S.done(cur); }
#undef PG8_SA
#undef PG8_SB
#undef PG8_STAGE
#undef PG8_LDA
#undef PG8_LDB
#undef PG8_MMA
#undef PG8_WAIT_V
#undef PG8_WAIT_L
#undef PG8_BAR
#undef PG8_SCHED
}
}
constexpr int NWAVES = 8;
constexpr int D = 2048, SEQ = 2048, MP = 8192, MS = 64, MT = MP + MS, MPAD = 8448, DEPTH = 4;
constexpr int AW = 1024, NH = 16, HD = 64, CCH = 1024, CK = 31, NIN = 5120, DFF = 5632, NGU = 2 * DFF, NMOD = 6 * D, WBUF = 2048, NBR = 12;
constexpr float EPS = 1e-6f;
constexpr float LOG2E = 1.4426950408889634f;
constexpr float QSCALE = 0.125f * LOG2E;
enum { I_XP = 0, I_XS, I_CP, I_CS, I_CK, I_CV, I_SC, I_GPM, I_GQM, I_GPF, I_GQF, I_WMOD, I_BMOD, I_WIN, I_GAO, I_CW, I_CB, I_LNG, I_LNB, I_WOUT, I_WGU, I_WDN, N_IN };
constexpr size_t O_YP = 0, O_YS = 16777216, O_KP = 16908288, O_VP = 50462720, O_CP = 84017152, O_KS = 84508672, O_VS = 151617536, O_CS = 218726400, O_END = 219709440;
constexpr size_t MiB = 1u << 20;
constexpr size_t WS_CTL = 0, CTL_ZERO_BYTES = 576 * 1024;
constexpr size_t SZ_WIN = (size_t)NIN * D * 2, SZ_WOUT = (size_t)D * D * 2, SZ_WGU = (size_t)NGU * D * 2, SZ_WDN = (size_t)D * DFF * 2;
constexpr size_t WS_WIN = 1 * MiB, WS_WOUT = WS_WIN + DEPTH * SZ_WIN, WS_WGU = WS_WOUT + DEPTH * SZ_WOUT, WS_WDN = WS_WGU + DEPTH * SZ_WGU;
constexpr size_t WS_XRES = WS_WDN + DEPTH * SZ_WDN;
constexpr size_t WS_H = WS_XRES + 65 * MiB;
constexpr size_t WS_Q = WS_H + 33 * MiB, WS_K = WS_Q + 17 * MiB, WS_V = WS_K + 17 * MiB, WS_U = WS_V + 17 * MiB;
constexpr size_t WS_O32 = WS_U + 17 * MiB;
constexpr size_t WS_MIXIN = WS_O32 + 33 * MiB;
constexpr size_t WS_MIX = WS_MIXIN + 33 * MiB;
constexpr size_t WS_FACT = WS_MIX + 33 * MiB;
constexpr size_t WS_F = WS_FACT + 91 * MiB;
constexpr size_t WS_SKP = WS_F + 33 * MiB;
constexpr size_t WS_MODP = WS_SKP + 2 * MiB;
constexpr size_t WS_MOD = WS_MODP + 36 * MiB;
constexpr size_t WS_OB = WS_MOD + 3 * MiB;
constexpr size_t WS_LSE = WS_OB + 49 * MiB;
constexpr size_t WS_YPRE = WS_LSE + 2 * MiB;
constexpr size_t WS_END = WS_YPRE + 17 * MiB;
static_assert(SZ_WIN == 20 * MiB && SZ_WOUT == 8 * MiB && SZ_WGU == 44 * MiB && SZ_WDN == 22 * MiB, "weight sizes");
static_assert((size_t)MT * D * 4 <= 65 * MiB && (size_t)MPAD * D * 2 <= 33 * MiB && (size_t)MPAD * 1024 * 2 <= 17 * MiB && (size_t)MT * 1024 * 4 <= 33 * MiB && (size_t)MPAD * DFF * 2 <= 91 * MiB, "ws map");
static_assert((size_t)16 * DEPTH * 12 * NMOD * 4 <= 36 * MiB && (size_t)DEPTH * 12 * NMOD * 4 <= 3 * MiB, "ws map 2");
constexpr int CW_BAR = 4096;
constexpr int RING_OFF = 0, RING_BYTES = 131072;
constexpr int LDSCTL_OFF = RING_BYTES, MISC_OFF = LDSCTL_OFF + 320;
constexpr int LDS_BYTES = 147456;

#define GAS __attribute__((address_space(1)))
#define LAS __attribute__((address_space(3)))
typedef unsigned short bf16;
typedef unsigned v4u __attribute__((ext_vector_type(4)));
typedef unsigned v2u __attribute__((ext_vector_type(2)));
typedef float f32x4 __attribute__((ext_vector_type(4)));
typedef float f32x2 __attribute__((ext_vector_type(2)));
typedef float f32x16 __attribute__((ext_vector_type(16)));
typedef short bf16x8 __attribute__((ext_vector_type(8)));
typedef GAS unsigned gu32;
#define RLX_AGENT __ATOMIC_RELAXED, __HIP_MEMORY_SCOPE_AGENT
#define LDS_WAIT() asm volatile("s_waitcnt lgkmcnt(0)" ::: "memory")
#define VM_WAIT() asm volatile("s_waitcnt vmcnt(0)" ::: "memory")
__device__ __forceinline__ unsigned f2bf(float f) { unsigned u = __builtin_bit_cast(unsigned, f); return (u + 0x7fffu + ((u >> 16) & 1u)) >> 16; }
__device__ __forceinline__ unsigned pk2(float lo, float hi) { return f2bf(lo) | (f2bf(hi) << 16); }
__device__ __forceinline__ float bflo(unsigned u) { return __builtin_bit_cast(float, u << 16); }
__device__ __forceinline__ float bfhi(unsigned u) { return __builtin_bit_cast(float, u & 0xffff0000u); }
__device__ __forceinline__ float sigm(float x) { return __builtin_amdgcn_rcpf(1.0f + __builtin_amdgcn_exp2f(-LOG2E * x)); }
#define XB_TMO      128
#define XB_XCNT(j)  (256  + 64 * (j))
#define XB_XSUB(j)  (1280 + 64 * (j))
#define XB_XGEN(j)  (2304 + 64 * (j))
#define XB_TOP      3328
#define XB_TOPGEN   3392
#define XCD_BAR_WORDS 3456
#define XB_SPIN_CAP (1u << 18)

__device__ __forceinline__ unsigned xb_ld(unsigned* p)              { return __hip_atomic_load(p, __ATOMIC_RELAXED, __HIP_MEMORY_SCOPE_AGENT); }
__device__ __forceinline__ unsigned xb_add(unsigned* p, unsigned v) { return __hip_atomic_fetch_add(p, v, __ATOMIC_RELAXED, __HIP_MEMORY_SCOPE_AGENT); }
__device__ __forceinline__ unsigned xb_xcc_id() { return (unsigned)__builtin_amdgcn_s_getreg((3 << 11) | 20) & 0xFu; }
#define XB_SPIN(cond, bar) do { unsigned _sp = 0; while (cond) { __builtin_amdgcn_s_sleep(1); \
    if ((++_sp & 255u) == 0u) { if (xb_ld(&(bar)[XB_TMO])) break; if (_sp > XB_SPIN_CAP) { atomicAdd(&(bar)[XB_TMO], 1u); break; } } } } while (0)

struct XcdBarrier {
    unsigned* bar; unsigned x;
    volatile LAS unsigned* st;
};

__device__ __forceinline__ XcdBarrier xcd_barrier_post(unsigned* bar, volatile LAS unsigned* st) {
    XcdBarrier b; b.bar = bar; b.x = xb_xcc_id(); b.st = st;
    if (threadIdx.x == 0) (void)xb_add(&bar[XB_XCNT(b.x)], 1u);
    return b;
}
__device__ __forceinline__ void xcd_barrier_complete(unsigned* bar, unsigned x, unsigned& nloc, unsigned& nx) {
    const unsigned G = gridDim.x * gridDim.y * gridDim.z;
    unsigned sum, cnt, mine, sp = 0u;
    for (;;) {
        sum = 0u; cnt = 0u; mine = 0u;
#pragma unroll
        for (unsigned j = 0; j < 16; ++j) { const unsigned c = xb_ld(&bar[XB_XCNT(j)]); sum += c; cnt += (c > 0u) ? 1u : 0u; mine = (j == x) ? c : mine; }
        if (sum == G) break;
        __builtin_amdgcn_s_sleep(1);
        if ((++sp & 255u) == 0u) { if (xb_ld(&bar[XB_TMO])) break; if (sp > XB_SPIN_CAP) { atomicAdd(&bar[XB_TMO], 1u); break; } }
    }
    nloc = mine > 0u ? mine : 1u; nx = cnt > 0u ? cnt : 1u;
}

__device__ __forceinline__ void xcd_barrier(const XcdBarrier& b) {
    asm volatile("s_waitcnt vmcnt(0)" ::: "memory");
    __syncthreads();
    if (threadIdx.x == 0) {
        unsigned* bar = b.bar; unsigned bx = b.x; asm volatile("" : "+s"(bx));
        __builtin_amdgcn_s_waitcnt(0);
        unsigned nloc = b.st[0], nx = b.st[1];
        if (nloc == 0u) { xcd_barrier_complete(bar, bx, nloc, nx); b.st[0] = nloc; b.st[1] = nx; }
        const unsigned old = xb_add(&bar[XB_XSUB(bx)], 1u);
        const unsigned gen = old / nloc;
        if (old + 1u == (gen + 1u) * nloc) {
            __builtin_amdgcn_fence(__ATOMIC_RELEASE, "agent");
            asm volatile("s_waitcnt vmcnt(0)" ::: "memory");
            const unsigned og = xb_add(&bar[XB_TOP], 1u);
            const unsigned tg = og / nx;
            if (og + 1u == (tg + 1u) * nx) xb_add(&bar[XB_TOPGEN], 1u);
            else XB_SPIN(xb_ld(&bar[XB_TOPGEN]) == tg, bar);
            __builtin_amdgcn_fence(__ATOMIC_ACQUIRE, "agent");
            xb_add(&bar[XB_XGEN(bx)], 1u);
            asm volatile("s_waitcnt vmcnt(0)" ::: "memory");
        } else {
            XB_SPIN(xb_ld(&bar[XB_XGEN(bx)]) == gen, bar);
            __builtin_amdgcn_fence(__ATOMIC_ACQUIRE, "agent");
            asm volatile("s_waitcnt vmcnt(0)" ::: "memory");
        }
    }
    __syncthreads();
}

struct Frame {
    LAS unsigned char* lds;
    volatile LAS unsigned* MISC;
    gu32* ctl;
    int tid, lane, wave, G, bid;
    float* out; unsigned char* ws;
};
__device__ __forceinline__ const float* inp_(const Frame& F, int i) {
    const LAS unsigned* p = (const LAS unsigned*)(F.lds + LDSCTL_OFF) + 2 * i; const unsigned lo = __builtin_amdgcn_readfirstlane(p[0]), hi = __builtin_amdgcn_readfirstlane(p[1]);
    return (const float*)(const GAS float*)(((unsigned long long)hi << 32) | lo);
}
#define INP(i) inp_(F, (i))
__device__ __forceinline__ int launder(int v) { asm volatile("" : "+v"(v)); return v; }
__device__ __forceinline__ int lane_id_now() { int l; asm volatile("v_mbcnt_lo_u32_b32 %0, -1, 0\n\tv_mbcnt_hi_u32_b32 %0, -1, %0" : "=v"(l)); return l; }
__device__ __forceinline__ float wave_sum(float v) {
#pragma unroll
    for (int o = 1; o < 64; o <<= 1) v += __shfl_xor(v, o);
    return v;
}
__device__ __forceinline__ float wave_max(float v) {
#pragma unroll
    for (int o = 1; o < 64; o <<= 1) v = fmaxf(v, __shfl_xor(v, o));
    return v;
}
__device__ __forceinline__ int batch_row(int m) { return m < MP ? (m >> 11) : 4 + ((m - MP) >> 3); }

__device__ __forceinline__ int map_win(int n) { if (n < 3072) return n; if (n < 4096) { const int c = n - 3072; return 3072 + 256 * (c >> 7) + (c & 127); } const int c = n - 4096; return 3072 + 256 * (c >> 7) + 128 + (c & 127); }
__device__ __forceinline__ int map_wgu(int n) { if (n < DFF) return 256 * (n >> 7) + (n & 127); const int c = n - DFF; return 256 * (c >> 7) + 128 + (c & 127); }
template <int MAP>
__device__ __forceinline__ void p0_transpose_item(const float* W, int K, int N, bf16* WT, LAS float* scr, int item, int lane) {
    const int nblk = N / 32, kb = item / nblk, nb = item % nblk, k0 = 64 * kb, n0 = 32 * nb;
    const int d0 = MAP == 1 ? map_win(n0) : (MAP == 2 ? map_wgu(n0) : n0);
    f32x4 wv[8];
#pragma unroll
    for (int i = 0; i < 8; ++i) wv[i] = __builtin_nontemporal_load((const f32x4*)(W + (size_t)(k0 + 8 * i + (lane >> 3)) * N + n0 + 4 * (lane & 7)));
#pragma unroll
    for (int i = 0; i < 8; ++i) { LAS float* d = scr + (8 * i + (lane >> 3)) * 33 + 4 * (lane & 7); d[0] = wv[i].x; d[1] = wv[i].y; d[2] = wv[i].z; d[3] = wv[i].w; }
    LDS_WAIT(); asm volatile("" ::: "memory");
    const int c = lane & 7;
#pragma unroll
    for (int j = 0; j < 4; ++j) { const int n = (lane >> 3) + 8 * j; const LAS float* s = scr + (8 * c) * 33 + n;
        v4u o; o.x = pk2(s[0 * 33], s[1 * 33]); o.y = pk2(s[2 * 33], s[3 * 33]); o.z = pk2(s[4 * 33], s[5 * 33]); o.w = pk2(s[6 * 33], s[7 * 33]);
        __builtin_nontemporal_store(o, (GAS v4u*)(WT + (size_t)(d0 + n) * K + k0 + 8 * c)); }
    LDS_WAIT(); asm volatile("" ::: "memory");
}
__device__ __forceinline__ void p0_transposes(Frame& F) {
    LAS float* scr = (LAS float*)(F.lds + RING_OFF + F.wave * 16384);
    const int gw = F.bid * NWAVES + F.wave, NGW = F.G * NWAVES;
    constexpr int I_IN = (D / 64) * (NIN / 32), I_OUT = (D / 64) * (D / 32), I_GU = (D / 64) * (NGU / 32), I_DN = (DFF / 64) * (D / 32), I_L = I_IN + I_OUT + I_GU + I_DN;
    for (int it = gw; it < DEPTH * I_L; it += NGW) {
        const int l = it / I_L; int r = it % I_L;
        if (r < I_IN) { p0_transpose_item<1>(INP(I_WIN) + (size_t)l * D * NIN, D, NIN, (bf16*)(F.ws + WS_WIN + l * SZ_WIN), scr, r, F.lane); continue; } r -= I_IN;
        if (r < I_OUT) { p0_transpose_item<0>(INP(I_WOUT) + (size_t)l * D * D, D, D, (bf16*)(F.ws + WS_WOUT + l * SZ_WOUT), scr, r, F.lane); continue; } r -= I_OUT;
        if (r < I_GU) { p0_transpose_item<2>(INP(I_WGU) + (size_t)l * D * NGU, D, NGU, (bf16*)(F.ws + WS_WGU + l * SZ_WGU), scr, r, F.lane); continue; } r -= I_GU;
        p0_transpose_item<0>(INP(I_WDN) + (size_t)l * DFF * D, DFF, D, (bf16*)(F.ws + WS_WDN + l * SZ_WDN), scr, r, F.lane);
    }
}
__device__ __forceinline__ void p0_mod_partials(Frame& F) {
    LAS float* cs = (LAS float*)(F.lds + RING_OFF);
    float* modp = (float*)(F.ws + WS_MODP);
    for (int it = F.bid; it < DEPTH * 16 * 6; it += F.G) {
        const int l = it / 96, kc = (it % 96) / 6, nb = it % 6, k0 = kc * 128;
        __syncthreads();
        for (int e = F.tid; e < 12 * 128; e += 512) { const int r = e >> 7, k = e & 127; const float c = r < 4 ? INP(I_CP)[r * D + k0 + k] : INP(I_CS)[(r - 4) * D + k0 + k]; cs[e] = c * sigm(c); }
        __syncthreads();
        const int n = nb * 2048 + F.tid * 4;
        const float* w = INP(I_WMOD) + ((size_t)l * D + k0) * NMOD + n;
        f32x4 acc[12];
#pragma unroll
        for (int r = 0; r < 12; ++r) acc[r] = (f32x4){0.f, 0.f, 0.f, 0.f};
#pragma unroll 4
        for (int k = 0; k < 128; ++k) { const f32x4 wv = __builtin_nontemporal_load((const f32x4*)(w + (size_t)k * NMOD));
#pragma unroll
            for (int r = 0; r < 12; ++r) acc[r] += wv * cs[r * 128 + k]; }
#pragma unroll
        for (int r = 0; r < 12; ++r) *(f32x4*)(modp + (((size_t)kc * DEPTH + l) * 12 + r) * NMOD + n) = acc[r];
    }
    __syncthreads();
}
__device__ __forceinline__ void p0_cache_copy(Frame& F) {
    const size_t nth = (size_t)F.G * 512, gt = (size_t)F.bid * 512 + F.tid;
    constexpr size_t BLK = (size_t)2040 * 1024 / 4;
    { const f32x4* src = (const f32x4*)INP(I_CK); f32x4* dst = (f32x4*)(F.out + O_KS);
        for (size_t i = gt; i < (size_t)32 * BLK; i += nth) { const size_t blk = i / BLK, off = i % BLK;
            const f32x4 v = __builtin_nontemporal_load(src + blk * (2048 * 256) + 8 * 256 + off);
            __builtin_nontemporal_store(v, dst + blk * (2048 * 256) + off); } }
    { const f32x4* src = (const f32x4*)INP(I_CV); f32x4* dst = (f32x4*)(F.out + O_VS);
        for (size_t i = gt; i < (size_t)32 * BLK; i += nth) { const size_t blk = i / BLK, off = i % BLK;
            const f32x4 v = __builtin_nontemporal_load(src + blk * (2048 * 256) + 8 * 256 + off);
            __builtin_nontemporal_store(v, dst + blk * (2048 * 256) + off); } }
}
constexpr int TAIL_SLOTS = 192, TAIL_F4 = 43520, BLK_F4 = 522240;
static_assert((long)TAIL_SLOTS * TAIL_F4 == 16L * BLK_F4, "tail copy slots cover the layer's window copy exactly");
__device__ __forceinline__ void tail_copy(Frame& F, int l, int slot) {
    const f32x4* sk = (const f32x4*)INP(I_CK); const f32x4* sv = (const f32x4*)INP(I_CV); f32x4* dk = (f32x4*)(F.out + O_KS); f32x4* dv = (f32x4*)(F.out + O_VS);
    const int tid = F.tid;
    for (int k0 = 0; k0 < TAIL_F4 / 512; k0 += 17) {
        f32x4 v[17]; size_t dofs[17]; int ts[17];
#pragma unroll
        for (int k = 0; k < 17; ++k) {
            const int i = slot * TAIL_F4 + (k0 + k) * 512 + tid, t = i / (8 * BLK_F4), rem = i % (8 * BLK_F4), blk = rem / BLK_F4, off = rem % BLK_F4;
            const size_t so = ((size_t)(l * 8 + blk) * 2048 + 8) * 256 + off; dofs[k] = (size_t)(l * 8 + blk) * 2048 * 256 + off; ts[k] = t;
            v[k] = __builtin_nontemporal_load((t ? sv : sk) + so);
        }
        __builtin_amdgcn_sched_barrier(0);
#pragma unroll
        for (int k = 0; k < 17; ++k) __builtin_nontemporal_store(v[k], (ts[k] ? dv : dk) + dofs[k]);
    }
}
__device__ __forceinline__ void p0_mod_reduce(Frame& F) {
    const float* modp = (const float*)(F.ws + WS_MODP); bf16* modb = (bf16*)(F.ws + WS_MOD);
    const int total = DEPTH * 12 * NMOD / 4;
    for (int i = F.bid * 512 + F.tid; i < total; i += F.G * 512) {
        const int e = i * 4, l = e / (12 * NMOD), n = e % NMOD, ch = n >> 11, c = n & 2047;
        f32x4 s = *(const f32x4*)(INP(I_BMOD) + (size_t)l * NMOD + n);
#pragma unroll
        for (int kc = 0; kc < 16; ++kc) s += *(const f32x4*)(modp + (size_t)kc * DEPTH * 12 * NMOD + e);
        if (ch == 1) s = (s + 1.0f) * *(const f32x4*)(INP(I_GPM) + (size_t)l * D + c);
        else if (ch == 2) s = s * *(const f32x4*)(INP(I_GQM) + (size_t)l * D + c);
        else if (ch == 4) s = (s + 1.0f) * *(const f32x4*)(INP(I_GPF) + (size_t)l * D + c);
        else if (ch == 5) s = s * *(const f32x4*)(INP(I_GQF) + (size_t)l * D + c);
        v2u w; w.x = pk2(s.x, s.y); w.y = pk2(s.z, s.w); *(v2u*)(modb + e) = w;
    }
}
#define UNP(v) ((f32x4){bflo((v).x), bfhi((v).x), bflo((v).y), bfhi((v).y)})
template <bool HAS_DELTA, bool XIN_F32, bool PROMPT = true>
__device__ __forceinline__ void resnorm_rows(Frame& F, const float* xin_p, const float* xin_s, float* out32_p, float* out32_s, const bf16* dbf, const float* dpart,
                                             const bf16* mgate, const bf16* msc, const bf16* msh, bf16* hb, unsigned* sig = nullptr) {
    bf16* XR = (bf16*)(F.ws + WS_XRES);
    const int gw = F.bid * NWAVES + F.wave, lane = F.lane;
    if (PROMPT) for (int m0 = 4 * gw; m0 < MP; m0 += 4 * F.G * NWAVES) {
        const int br = m0 >> 11;
        v4u v1[4], v2[4], v3[4];
#pragma unroll
        for (int j = 0; j < 4; ++j) { const int c = 8 * lane + 512 * j;
            if (HAS_DELTA) v1[j] = *(const v4u*)(mgate + (size_t)br * NMOD + c);
            if (hb) { v2[j] = *(const v4u*)(msc + (size_t)br * NMOD + c); v3[j] = *(const v4u*)(msh + (size_t)br * NMOD + c); } }
        f32x4 xf[2][4][2]; v4u xq[2][4], dq[2][4];
#define UNL(v) ((f32x4){bflo((v).x), bfhi((v).x), bflo((v).y), bfhi((v).y)})
#define UNH(v) ((f32x4){bflo((v).z), bfhi((v).z), bflo((v).w), bfhi((v).w)})
#define LOADROW(buf, mm) do { _Pragma("unroll") for (int j = 0; j < 4; ++j) { const size_t o_ = (size_t)(mm) * D + 8 * lane + 512 * j; \
            if (XIN_F32) { xf[buf][j][0] = __builtin_nontemporal_load((const f32x4*)(xin_p + o_)); xf[buf][j][1] = __builtin_nontemporal_load((const f32x4*)(xin_p + o_ + 4)); } \
            else xq[buf][j] = __builtin_nontemporal_load((const v4u*)(XR + o_)); \
            if (HAS_DELTA) dq[buf][j] = __builtin_nontemporal_load((const v4u*)(dbf + o_)); } } while (0)
        LOADROW(0, m0);
#pragma unroll
        for (int i = 0; i < 4; ++i) {
            const int m = m0 + i, cur = i & 1;
            if (i < 3) LOADROW(cur ^ 1, m + 1);
            __builtin_amdgcn_sched_barrier(0);
#pragma unroll
            for (int j = 0; j < 4; ++j) { asm volatile("" : "+v"(v1[j]), "+v"(v2[j]), "+v"(v3[j])); }
            f32x4 x[4][2];
#pragma unroll
            for (int j = 0; j < 4; ++j) { x[j][0] = XIN_F32 ? xf[cur][j][0] : UNL(xq[cur][j]); x[j][1] = XIN_F32 ? xf[cur][j][1] : UNH(xq[cur][j]); }
            if (HAS_DELTA) {
                float ss = 0.f;
#pragma unroll
                for (int j = 0; j < 4; ++j) { const f32x4 t = UNL(dq[cur][j]), u = UNH(dq[cur][j]); ss += ((t.x * t.x + t.y * t.y) + (t.z * t.z + t.w * t.w)) + ((u.x * u.x + u.y * u.y) + (u.z * u.z + u.w * u.w)); }
                const float r = 1.0f / sqrtf(wave_sum(ss) * (1.0f / D) + EPS);
#pragma unroll
                for (int j = 0; j < 4; ++j) { x[j][0] = x[j][0] + UNL(v1[j]) * (UNL(dq[cur][j]) * r); x[j][1] = x[j][1] + UNH(v1[j]) * (UNH(dq[cur][j]) * r); }
            }
            if (out32_p) {
#pragma unroll
                for (int j = 0; j < 4; ++j) { float* o = out32_p + (size_t)m * D + 8 * lane + 512 * j; *(f32x4*)o = x[j][0]; *(f32x4*)(o + 4) = x[j][1]; }
            } else {
#pragma unroll
                for (int j = 0; j < 4; ++j) { v4u w; w.x = pk2(x[j][0].x, x[j][0].y); w.y = pk2(x[j][0].z, x[j][0].w); w.z = pk2(x[j][1].x, x[j][1].y); w.w = pk2(x[j][1].z, x[j][1].w);
                    __builtin_nontemporal_store(w, (v4u*)(XR + (size_t)m * D + 8 * lane + 512 * j)); }
            }
            if (hb) {
                float ss = 0.f;
#pragma unroll
                for (int j = 0; j < 4; ++j) { const f32x4 t = x[j][0], u = x[j][1]; ss += ((t.x * t.x + t.y * t.y) + (t.z * t.z + t.w * t.w)) + ((u.x * u.x + u.y * u.y) + (u.z * u.z + u.w * u.w)); }
                const float r = 1.0f / sqrtf(wave_sum(ss) * (1.0f / D) + EPS);
#pragma unroll
                for (int j = 0; j < 4; ++j) { const f32x4 h0 = x[j][0] * r * UNL(v2[j]) + UNL(v3[j]), h1 = x[j][1] * r * UNH(v2[j]) + UNH(v3[j]);
                    v4u w; w.x = pk2(h0.x, h0.y); w.y = pk2(h0.z, h0.w); w.z = pk2(h1.x, h1.y); w.w = pk2(h1.z, h1.w); *(v4u*)(hb + (size_t)m * D + 8 * lane + 512 * j) = w; }
            }
        }
#undef LOADROW
#undef UNL
#undef UNH
    }
    for (int it = F.G - 1 - F.bid; it < MS / 4; it += F.G) {
        LAS float* red = (LAS float*)(F.lds + RING_OFF);
        const int ms0 = it * 4, br = 4 + (ms0 >> 3), c = 4 * F.tid;
        f32x4 x[4], d[4];
#pragma unroll
        for (int i = 0; i < 4; ++i) { const size_t o = (size_t)(ms0 + i) * D + c;
            if (XIN_F32) x[i] = *(const f32x4*)(xin_s + o); else { const v2u q = *(const v2u*)(XR + (size_t)MP * D + o); x[i] = UNP(q); }
            if (HAS_DELTA) { f32x4 s = *(const f32x4*)(dpart + o);
#pragma unroll
                for (int q = 1; q < 4; ++q) s += *(const f32x4*)(dpart + (size_t)q * MS * D + o);
                d[i] = s; } }
        __syncthreads();
        if (HAS_DELTA) {
            const v2u g1 = *(const v2u*)(mgate + (size_t)br * NMOD + c);
#pragma unroll
            for (int i = 0; i < 4; ++i) { const float s = wave_sum((d[i].x * d[i].x + d[i].y * d[i].y) + (d[i].z * d[i].z + d[i].w * d[i].w)); if (lane == 0) red[i * 8 + F.wave] = s; }
            __syncthreads();
#pragma unroll
            for (int i = 0; i < 4; ++i) { const f32x4 a = *(const LAS f32x4*)(red + i * 8), b = *(const LAS f32x4*)(red + i * 8 + 4);
                const float r = 1.0f / sqrtf(((a.x + a.y) + (a.z + a.w) + (b.x + b.y) + (b.z + b.w)) * (1.0f / D) + EPS);
                x[i] = x[i] + UNP(g1) * (d[i] * r); }
        }
#pragma unroll
        for (int i = 0; i < 4; ++i) { const size_t o = (size_t)(ms0 + i) * D + c;
            if (out32_s) *(f32x4*)(out32_s + o) = x[i]; else { v2u w; w.x = pk2(x[i].x, x[i].y); w.y = pk2(x[i].z, x[i].w); *(v2u*)(XR + (size_t)MP * D + o) = w; } }
        if (hb) {
            const v2u g2 = *(const v2u*)(msc + (size_t)br * NMOD + c), g3 = *(const v2u*)(msh + (size_t)br * NMOD + c);
#pragma unroll
            for (int i = 0; i < 4; ++i) { const float s = wave_sum((x[i].x * x[i].x + x[i].y * x[i].y) + (x[i].z * x[i].z + x[i].w * x[i].w)); if (lane == 0) red[32 + i * 8 + F.wave] = s; }
            __syncthreads();
#pragma unroll
            for (int i = 0; i < 4; ++i) { const f32x4 a = *(const LAS f32x4*)(red + 32 + i * 8), b = *(const LAS f32x4*)(red + 32 + i * 8 + 4);
                const float r = 1.0f / sqrtf(((a.x + a.y) + (a.z + a.w) + (b.x + b.y) + (b.z + b.w)) * (1.0f / D) + EPS);
                const f32x4 h = x[i] * r * UNP(g2) + UNP(g3);
                __hip_atomic_store((unsigned long long*)(hb + (size_t)(MP + ms0 + i) * D + c), ((unsigned long long)pk2(h.z, h.w) << 32) | (unsigned long long)pk2(h.x, h.y), __ATOMIC_RELAXED, __HIP_MEMORY_SCOPE_AGENT); }
        }
        if (sig) asm volatile("s_waitcnt vmcnt(0)" ::: "memory");
        __syncthreads();
        if (sig && F.tid == 0) __hip_atomic_fetch_add(sig, 1u, __ATOMIC_RELAXED, __HIP_MEMORY_SCOPE_AGENT);
    }
}
#undef UNP
__device__ __forceinline__ void attn_sample_item(Frame& F, int l, int it, LAS float* pscr) {
    const int br = it % 3, mh = it / 3, ms = mh >> 4, h = mh & 15, b = ms >> 3, m = MP + ms, dsh = 2 * br, lane = F.lane;
    const bf16* Qb = (const bf16*)(F.ws + WS_Q); const bf16* Kb = (const bf16*)(F.ws + WS_K); const bf16* Vb = (const bf16*)(F.ws + WS_V);
    bf16* OB = (bf16*)(F.ws + WS_OB) + (size_t)br * MT * 1024; float* LSE = (float*)(F.ws + WS_LSE) + (size_t)br * MT * 16;
    const int tpos = WBUF + (ms & 7);
    const float slope2 = exp2f(-0.5f * (float)(h + 1)) * LOG2E;
    const float* ck = INP(I_CK) + ((size_t)(l * 8 + b) * WBUF) * 1024 + h * 64;
    const float* cv = INP(I_CV) + ((size_t)(l * 8 + b) * WBUF) * 1024 + h * 64;
    const bf16* kn = Kb + (size_t)(MP + b * 8) * 1024 + h * 64;
    const bf16* vn = Vb + (size_t)(MP + b * 8) * 1024 + h * 64;
    v4u qv[8];
#pragma unroll
    for (int c = 0; c < 8; ++c) qv[c] = *(const v4u*)(Qb + (size_t)m * 1024 + h * 64 + 8 * c);
    const int d0 = lane << dsh, d1 = (lane + 64) << dsh, i0 = tpos - d0, i1 = tpos - d1, i128 = tpos - (128 << dsh);
    const bool old0 = i0 < WBUF;
    const float* kr0 = ck + (size_t)(old0 ? i0 : WBUF - 1) * 1024; const float* kr1 = ck + (size_t)i1 * 1024; const bf16* kq0 = kn + (size_t)(old0 ? 0 : i0 - WBUF) * 1024;
    f32x4 ka[16], kb[16]; v4u kn8[8];
#pragma unroll
    for (int c = 0; c < 16; ++c) { ka[c] = *(const f32x4*)(kr0 + 4 * c); kb[c] = *(const f32x4*)(kr1 + 4 * c); }
#pragma unroll
    for (int c = 0; c < 8; ++c) kn8[c] = *(const v4u*)(kq0 + 8 * c);
    const float k128 = ck[(size_t)i128 * 1024 + lane]; const float q128 = bflo((unsigned)Qb[(size_t)m * 1024 + h * 64 + lane]);
    __builtin_amdgcn_sched_barrier(0);
    float a0 = 0.f, a1 = 0.f, an = 0.f;
#pragma unroll
    for (int c = 0; c < 8; ++c) { const v4u q = qv[c]; const f32x4 x0 = ka[2 * c], x1 = ka[2 * c + 1], y0 = kb[2 * c], y1 = kb[2 * c + 1]; const v4u k = kn8[c];
        a0 += bflo(q.x) * x0.x + bfhi(q.x) * x0.y + bflo(q.y) * x0.z + bfhi(q.y) * x0.w + bflo(q.z) * x1.x + bfhi(q.z) * x1.y + bflo(q.w) * x1.z + bfhi(q.w) * x1.w;
        a1 += bflo(q.x) * y0.x + bfhi(q.x) * y0.y + bflo(q.y) * y0.z + bfhi(q.y) * y0.w + bflo(q.z) * y1.x + bfhi(q.z) * y1.y + bflo(q.w) * y1.z + bfhi(q.w) * y1.w;
        an += bflo(q.x) * bflo(k.x) + bfhi(q.x) * bfhi(k.x) + bflo(q.y) * bflo(k.y) + bfhi(q.y) * bfhi(k.y) + bflo(q.z) * bflo(k.z) + bfhi(q.z) * bfhi(k.z) + bflo(q.w) * bflo(k.w) + bfhi(q.w) * bfhi(k.w); }
    const float s0 = (old0 ? a0 : an) - slope2 * (float)d0, s1 = a1 - slope2 * (float)d1;
    const float s128 = wave_sum(k128 * q128) - slope2 * (float)(128 << dsh);
    const float mx = fmaxf(wave_max(fmaxf(s0, s1)), s128);
    const float p0 = __builtin_amdgcn_exp2f(s0 - mx), p1 = __builtin_amdgcn_exp2f(s1 - mx), p128 = __builtin_amdgcn_exp2f(s128 - mx);
    const float sum = wave_sum(p0 + p1) + p128, inv = 1.0f / sum;
    pscr[lane] = p0 * inv; pscr[64 + lane] = p1 * inv; if (lane < 4) pscr[128 + lane] = lane == 0 ? p128 * inv : 0.f;
    LDS_WAIT(); asm volatile("" ::: "memory");
    const int ks = lane >> 4, dq = lane & 15;
    f32x4 vc[33]; v2u vw[2];
#pragma unroll
    for (int jt = 0; jt < 33; ++jt) { const int j = 4 * jt + ks; int idx = tpos - (j << dsh); idx = idx < 0 ? 0 : (idx >= WBUF ? WBUF - 1 : idx);
        vc[jt] = *(const f32x4*)(cv + (size_t)idx * 1024 + 4 * dq); }
#pragma unroll
    for (int jt = 0; jt < 2; ++jt) { const int j = 4 * jt + ks; const int idx = tpos - (j << dsh); vw[jt] = *(const v2u*)(vn + (size_t)(idx >= WBUF ? idx - WBUF : 0) * 1024 + 4 * dq); }
    __builtin_amdgcn_sched_barrier(0);
    f32x4 acc = (f32x4){0.f, 0.f, 0.f, 0.f};
#pragma unroll
    for (int jt = 0; jt < 33; ++jt) { const int j = 4 * jt + ks; const float p = pscr[j]; f32x4 v = vc[jt];
        if (jt < 2) { const int idx = tpos - (j << dsh); if (idx >= WBUF) v = (f32x4){bflo(vw[jt].x), bfhi(vw[jt].x), bflo(vw[jt].y), bfhi(vw[jt].y)}; }
        acc += v * p; }
#pragma unroll
    for (int e = 0; e < 4; ++e) { acc[e] += __shfl_xor(acc[e], 16); acc[e] += __shfl_xor(acc[e], 32); }
    if (lane < 16) { v2u w; w.x = pk2(acc.x, acc.y); w.y = pk2(acc.z, acc.w); *(v2u*)(OB + (size_t)m * 1024 + h * 64 + 4 * dq) = w; }
    if (lane == 0) LSE[(size_t)m * 16 + h] = mx + __builtin_amdgcn_logf(sum);
    LDS_WAIT(); asm volatile("" ::: "memory");
}
__device__ __forceinline__ void attn_sample_phase(Frame& F, int l) {
    LAS float* pscr = (LAS float*)(F.lds + RING_OFF + F.wave * 16384);
    const int gwr = (F.G - 1 - F.bid) * NWAVES + F.wave, NGW = F.G * NWAVES;
    for (int it = gwr; it < MS * NH * 3; it += NGW) attn_sample_item(F, l, it, pscr);
}
typedef const __attribute__((address_space(3))) char* lds_cptr;
typedef short v4i16_t __attribute__((ext_vector_type(4)));
typedef short s16x4 __attribute__((ext_vector_type(4)));
__device__ __forceinline__ s16x4 vtr(lds_cptr p) { return __builtin_bit_cast(s16x4, __builtin_amdgcn_ds_read_tr16_b64_v4i16((__attribute__((address_space(3))) v4i16_t*)p)); }
__device__ __forceinline__ unsigned cvtpk(float lo, float hi) { typedef float f2 __attribute__((ext_vector_type(2))); typedef __bf16 b2 __attribute__((ext_vector_type(2))); f2 v = {lo, hi}; b2 b = __builtin_convertvector(v, b2); return __builtin_bit_cast(unsigned, b); }
__device__ __forceinline__ void glds16(const void* gsrc, unsigned lds_dst) { unsigned keep;
    asm volatile("s_mov_b32 %0, m0\n\ts_mov_b32 m0, %2\n\ts_nop 0\n\tglobal_load_lds_dwordx4 %1, off\n\ts_mov_b32 m0, %0" : "=&s"(keep) : "v"(gsrc), "s"(lds_dst) : "memory"); }
struct AttnC { int br, dsh, r, qb, h; size_t rowb; };
__device__ __forceinline__ AttnC attn_coord(int w, int wave) {
    AttnC c; c.br = w >> 9; const int bh = (w & 511) >> 3, e = (w & 7) * 8 + wave, sh = 6 - 2 * c.br;
    c.dsh = 2 * c.br; c.r = e >> sh; c.qb = e & ((1 << sh) - 1); c.h = bh & 15; c.rowb = (size_t)(bh >> 4) * SEQ; return c;
}
__device__ __forceinline__ void attn_load_q(const Frame& F, const AttnC& c, int lane, bf16x8 (&qf)[4]) {
    const bf16* Qb = (const bf16*)(F.ws + WS_Q); const int r32 = lane & 31, hi = lane >> 5;
    const int tq = ((32 * c.qb + r32) << c.dsh) + c.r;
#pragma unroll
    for (int s = 0; s < 4; ++s) qf[s] = *(const bf16x8*)(Qb + (c.rowb + tq) * 1024 + c.h * 64 + 16 * s + 8 * hi);
}
template <int KB0, int KB1>
__device__ __forceinline__ void attn_load_k(const Frame& F, const AttnC& c, int lane, bf16x8 (&kf)[5][4]) {
    const bf16* Kb = (const bf16*)(F.ws + WS_K); const int r32 = lane & 31, hi = lane >> 5;
#pragma unroll
    for (int kb = KB0; kb < KB1; ++kb) {
        int ap = 32 * (c.qb - 4 + kb) + r32; ap = ap < 0 ? 0 : ap;
        const bf16* kr = Kb + (c.rowb + (size_t)((ap << c.dsh) + c.r)) * 1024 + c.h * 64 + 8 * hi;
#pragma unroll
        for (int s = 0; s < 4; ++s) kf[kb][s] = *(const bf16x8*)(kr + 16 * s);
    }
}
template <bool VISIBLE>
__device__ __forceinline__ void attn_v_dma(const Frame& F, const AttnC& c, int lane, LAS unsigned char* wl, int kb, int slot) {
    const bf16* Vb = (const bf16*)(F.ws + WS_V); const int vkey = (lane & 31) >> 2, vch = 4 * (lane >> 5) + (lane & 3);
#pragma unroll
    for (int i = 0; i < 4; ++i) { int ap = 32 * (c.qb - 4 + kb) + 8 * i + vkey; ap = ap < 0 ? 0 : ap;
        const bf16* src = Vb + (c.rowb + (size_t)((ap << c.dsh) + c.r)) * 1024 + c.h * 64 + vch * 8;
        if (VISIBLE) __builtin_amdgcn_global_load_lds((const unsigned*)src, (LAS unsigned*)(wl + slot * 4096 + i * 1024), 16, 0, 0);
        else glds16(src, (unsigned)__builtin_amdgcn_readfirstlane((unsigned)(uintptr_t)wl + slot * 4096 + i * 1024)); }
}
__device__ __forceinline__ AttnC attn_coord_i(int I) {
    AttnC c; c.br = I >> 12; const int rem = I & 4095, bh = rem >> 6, e = rem & 63, sh = 6 - 2 * c.br;
    c.dsh = 2 * c.br; c.r = e >> sh; c.qb = e & ((1 << sh) - 1); c.h = bh & 15; c.rowb = (size_t)(bh >> 4) * SEQ; return c;
}
__device__ __forceinline__ void attn_qk(const bf16x8 (&qf)[4], const bf16x8 (&kf)[5][4], float c1, f32x16 (&S)[5]) {
#pragma unroll
    for (int kb = 0; kb < 5; ++kb) {
        f32x16 acc;
#pragma unroll
        for (int i = 0; i < 16; ++i) acc[i] = c1;
#pragma unroll
        for (int s = 0; s < 4; ++s) acc = __builtin_amdgcn_mfma_f32_32x32x16_bf16(kf[kb][s], qf[s], acc, 0, 0, 0);
        S[kb] = acc;
    }
}
__device__ __forceinline__ float attn_sd(const AttnC& c) { return exp2f(-0.5f * (float)(c.h + 1)) * LOG2E * (float)(1 << c.dsh); }
#define ATTN_W(n) asm volatile("s_waitcnt vmcnt(" #n ")" ::: "memory")
__device__ __forceinline__ void attn_mfma_phase(Frame& F) {
    LAS unsigned char* wl = F.lds + RING_OFF + F.wave * 16384;
    const int lane = F.lane, r32 = lane & 31, hi = lane >> 5;
    constexpr int NITEM = 3 * 64 * 64;
    const int NW = F.G * NWAVES, per = (NITEM + NW - 1) / NW;
    int I = (F.bid * NWAVES + F.wave) * per; asm volatile("" : "+s"(I));
    const int Iend = (I + per < NITEM) ? I + per : NITEM;
    if (I >= Iend) return;
    f32x16 S[5]; bf16x8 kf[5][4];
    { const AttnC c = attn_coord_i(I); bf16x8 qf[4];
      attn_load_q(F, c, lane, qf); attn_load_k<0, 5>(F, c, lane, kf);
#pragma unroll
      for (int kb = 0; kb < 4; ++kb) attn_v_dma<false>(F, c, lane, wl, kb, (c.qb - 4 + kb) & 3);
      attn_qk(qf, kf, attn_sd(c) * (float)(4 * hi - 128 - r32), S); }
    bool restart = true;
#pragma unroll 1
    for (;;) {
        const AttnC c = attn_coord_i(I);
        const bool has_next = I + 1 < Iend, same = has_next && (((I + 1) & ((64 >> c.dsh) - 1)) != 0);
        const int qb = c.qb;
        const float sd = attn_sd(c);
        bf16* OB = (bf16*)(F.ws + WS_OB) + (size_t)c.br * MT * 1024; float* LSE = (float*)(F.ws + WS_LSE) + (size_t)c.br * MT * 16;
        const int tq = ((32 * qb + r32) << c.dsh) + c.r;
        if (has_next) { int In = I + 1; asm volatile("" : "+s"(In)); const AttnC cn = attn_coord_i(In);
            if (same) {
#pragma unroll
                for (int kb = 0; kb < 4; ++kb)
#pragma unroll
                    for (int s = 0; s < 4; ++s) kf[kb][s] = kf[kb + 1][s];
                attn_load_k<4, 5>(F, cn, lane, kf);
            } else attn_load_k<0, 5>(F, cn, lane, kf);
        }
        __builtin_amdgcn_sched_barrier(0);
        float mx = -INFINITY;
#pragma unroll
        for (int kb = 0; kb < 5; ++kb) {
            const bool blk_ok = (qb - 4 + kb) >= 0;
#pragma unroll
            for (int i = 0; i < 16; ++i) { const int ikb = (i & 3) + 8 * (i >> 2), ik = ikb + 4 * hi;
                float s = S[kb][i] + sd * (float)(32 * kb + ikb);
                bool ok = blk_ok;
                if (kb == 0) ok = ok && (ik >= r32);
                if (kb == 4) ok = ok && (ik <= r32);
                s = ok ? s : -INFINITY; S[kb][i] = s; mx = fmaxf(mx, s); }
        }
        mx = fmaxf(mx, __shfl_xor(mx, 32));
        float l = 0.f;
        f32x16 O[2];
#pragma unroll
        for (int i = 0; i < 16; ++i) { O[0][i] = 0.f; O[1][i] = 0.f; }
        const lds_cptr vb = (lds_cptr)wl + (4 * hi + ((lane >> 2) & 3)) * 64 + ((lane >> 4) & 1) * 32 + (lane & 3) * 8;
        bf16x8 qn[4];
#pragma unroll
        for (int kb = 0; kb < 5; ++kb) {
            const int slot = (qb - 4 + kb) & 3;
            bf16x8 pf[2];
#pragma unroll
            for (int i = 0; i < 16; ++i) { const float p = __builtin_amdgcn_exp2f(S[kb][i] - mx); S[kb][i] = p; l += p; }
#pragma unroll
            for (int s = 0; s < 2; ++s) { v4u wv; wv.x = cvtpk(S[kb][8 * s + 0], S[kb][8 * s + 1]); wv.y = cvtpk(S[kb][8 * s + 2], S[kb][8 * s + 3]); wv.z = cvtpk(S[kb][8 * s + 4], S[kb][8 * s + 5]); wv.w = cvtpk(S[kb][8 * s + 6], S[kb][8 * s + 7]);
                pf[s] = __builtin_bit_cast(bf16x8, wv); }
            if (kb == 0 && restart) { if (!has_next) ATTN_W(0); else if (same) ATTN_W(4); else ATTN_W(20); }
            if (kb == 4) ATTN_W(0);
            const lds_cptr vs = vb + slot * 4096;
#pragma unroll
            for (int s = 0; s < 2; ++s)
#pragma unroll
                for (int dt = 0; dt < 2; ++dt) { const s16x4 lo = vtr(vs + s * 2048 + dt * 512), hh = vtr(vs + s * 2048 + dt * 512 + 1024);
                    const bf16x8 vf = (bf16x8){lo[0], lo[1], lo[2], lo[3], hh[0], hh[1], hh[2], hh[3]};
                    O[dt] = __builtin_amdgcn_mfma_f32_32x32x16_bf16(vf, pf[s], O[dt], 0, 0, 0); }
            if (kb == 0) { asm volatile("s_waitcnt lgkmcnt(0)" ::: "memory"); attn_v_dma<false>(F, c, lane, wl, 4, qb & 3);
                if (has_next) { int In = I + 1; asm volatile("" : "+s"(In)); attn_load_q(F, attn_coord_i(In), lane, qn); } }
        }
        l += __shfl_xor(l, 32);
        const float inv = 1.0f / l;
        bf16* orow = OB + (c.rowb + tq) * 1024 + c.h * 64 + 4 * hi;
#pragma unroll
        for (int dt = 0; dt < 2; ++dt)
#pragma unroll
            for (int g = 0; g < 4; ++g) { v2u wv; wv.x = cvtpk(O[dt][4 * g + 0] * inv, O[dt][4 * g + 1] * inv); wv.y = cvtpk(O[dt][4 * g + 2] * inv, O[dt][4 * g + 3] * inv);
                *(v2u*)(orow + 32 * dt + 8 * g) = wv; }
        if (hi == 0) LSE[(c.rowb + tq) * 16 + c.h] = mx + __builtin_amdgcn_logf(l);
        asm volatile("s_waitcnt lgkmcnt(0)" ::: "memory");
        if (!has_next) break;
        ++I; asm volatile("" : "+s"(I));
        { const AttnC cn = attn_coord_i(I);
          if (!same) {
#pragma unroll
              for (int kb = 0; kb < 4; ++kb) attn_v_dma<false>(F, cn, lane, wl, kb, (cn.qb - 4 + kb) & 3);
          }
          restart = !same;
          attn_qk(qn, kf, attn_sd(cn) * (float)(4 * hi - 128 - r32), S); }
    }
    asm volatile("s_waitcnt vmcnt(0) lgkmcnt(0)" ::: "memory");
}
#undef ATTN_W
template <int NTOK, bool SAMPLE>
__device__ __forceinline__ void conv_run(Frame& F, int l, int b, int t0, const f32x2 (&w)[CK], const f32x2 bias, int c) {
    const bf16* Ub = (const bf16*)(F.ws + WS_U); bf16* YP = (bf16*)(F.ws + WS_YPRE);
    unsigned ue[NTOK + 30];
#pragma unroll
    for (int j = 0; j < NTOK + 30; ++j) {
        if (SAMPLE) { if (j < 30) { const f32x2 v = *(const f32x2*)(INP(I_SC) + ((size_t)(l * 8 + b) * 30 + j) * CCH + c); ue[j] = pk2(v.x, v.y); }
                      else ue[j] = *(const unsigned*)(Ub + (size_t)(MP + b * 8 + j - 30) * 1024 + c); }
        else { const int t = t0 - 30 + j; ue[j] = t < 0 ? 0u : *(const unsigned*)(Ub + (size_t)(b * SEQ + t) * 1024 + c); }
    }
    if (SAMPLE) { float* co = F.out + O_CS + (size_t)(l * 8 + b) * 30 * CCH + c;
#pragma unroll
        for (int j = 0; j < 30; ++j) { f32x2 v; if (j + 8 < 30) v = *(const f32x2*)(INP(I_SC) + ((size_t)(l * 8 + b) * 30 + j + 8) * CCH + c); else v = (f32x2){bflo(ue[j + 8]), bfhi(ue[j + 8])}; *(f32x2*)(co + (size_t)j * CCH) = v; }
    } else if (t0 + NTOK == SEQ) { float* co = F.out + O_CP + (size_t)(l * 4 + b) * 30 * CCH + c;
#pragma unroll
        for (int j = 0; j < 30; ++j) { const unsigned v = ue[j + NTOK]; *(f32x2*)(co + (size_t)j * CCH) = (f32x2){bflo(v), bfhi(v)}; }
    }
    f32x2 uf[NTOK + 30];
#pragma unroll
    for (int j = 0; j < NTOK + 30; ++j) uf[j] = (f32x2){bflo(ue[j]), bfhi(ue[j])};
#pragma unroll
    for (int t = 0; t < NTOK; ++t) { f32x2 a = bias;
#pragma unroll
        for (int k = 0; k < CK; ++k) a += w[k] * uf[t + k];
        const size_t row = SAMPLE ? (size_t)(MP + b * 8 + t) : (size_t)(b * SEQ + t0 + t);
        *(unsigned*)(YP + row * 1024 + c) = pk2(a.x, a.y); }
}
__device__ __forceinline__ void conv_phase(Frame& F, int l) {
    const int c = F.wave * 128 + 2 * F.lane;
    f32x2 w[CK];
#pragma unroll
    for (int k = 0; k < CK; ++k) w[k] = *(const f32x2*)(INP(I_CW) + ((size_t)l * CK + k) * CCH + c);
    const f32x2 bias = *(const f32x2*)(INP(I_CB) + (size_t)l * CCH + c);
    for (int it = F.bid; it < 512 + 8; it += F.G) {
        if (it < 512) conv_run<16, false>(F, l, it >> 7, (it & 127) * 16, w, bias, c);
        else conv_run<8, true>(F, l, it - 512, 0, w, bias, c);
    }
}
__device__ __forceinline__ void onorm_phase(Frame& F, int l) {
    bf16* MIXIN = (bf16*)(F.ws + WS_MIXIN); const float* g = INP(I_GAO) + (size_t)l * AW;
    const bf16* OB = (const bf16*)(F.ws + WS_OB); const float* LSE = (const float*)(F.ws + WS_LSE); const bf16* YP = (const bf16*)(F.ws + WS_YPRE);
    const float* lng = INP(I_LNG) + (size_t)l * CCH; const float* lnb = INP(I_LNB) + (size_t)l * CCH;
    const int gw = F.bid * NWAVES + F.wave, NGW = F.G * NWAVES, lane = F.lane;
#define STOREV(it_) do { v4u w0, w1; \
        w0.x = pk2(v[0].x, v[0].y); w0.y = pk2(v[0].z, v[0].w); w0.z = pk2(v[1].x, v[1].y); w0.w = pk2(v[1].z, v[1].w); \
        w1.x = pk2(v[2].x, v[2].y); w1.y = pk2(v[2].z, v[2].w); w1.z = pk2(v[3].x, v[3].y); w1.w = pk2(v[3].z, v[3].w); \
        bf16* dst = MIXIN + (size_t)((it_) >> 1) * D + ((it_) & 1) * 1024 + 16 * lane; *(v4u*)dst = w0; *(v4u*)(dst + 8) = w1; } while (0)
    if ((gw & 1) == 0) {
        const int hd = lane >> 2;
        float ls[2][3]; v4u ob[2][6];
#define LOAD0(b, it_) do { const int m_ = (it_) >> 1; \
            ls[b][0] = LSE[(size_t)m_ * 16 + hd]; ls[b][1] = LSE[((size_t)MT + m_) * 16 + hd]; ls[b][2] = LSE[((size_t)2 * MT + m_) * 16 + hd]; \
            _Pragma("unroll") for (int q = 0; q < 3; ++q) { ob[b][2 * q] = *(const v4u*)(OB + ((size_t)q * MT + m_) * 1024 + 16 * lane); ob[b][2 * q + 1] = *(const v4u*)(OB + ((size_t)q * MT + m_) * 1024 + 16 * lane + 8); } } while (0)
#define MRG(A, B, C, k) (w0 * bflo(A[k]) + w1 * bflo(B[k]) + w2 * bflo(C[k])), (w0 * bfhi(A[k]) + w1 * bfhi(B[k]) + w2 * bfhi(C[k]))
#define COMP0(b, it_) do { f32x4 v[4]; \
            const float l0 = ls[b][0], l1 = ls[b][1], l2 = ls[b][2]; \
            const float mx = fmaxf(l0, fmaxf(l1, l2)); float w0 = __builtin_amdgcn_exp2f(l0 - mx), w1 = __builtin_amdgcn_exp2f(l1 - mx), w2 = __builtin_amdgcn_exp2f(l2 - mx); \
            const float inv = 1.0f / (w0 + w1 + w2); w0 *= inv; w1 *= inv; w2 *= inv; \
            const v4u a0 = ob[b][0], a1 = ob[b][1], b0 = ob[b][2], b1 = ob[b][3], c0 = ob[b][4], c1 = ob[b][5]; \
            v[0] = (f32x4){MRG(a0, b0, c0, 0), MRG(a0, b0, c0, 1)}; v[1] = (f32x4){MRG(a0, b0, c0, 2), MRG(a0, b0, c0, 3)}; \
            v[2] = (f32x4){MRG(a1, b1, c1, 0), MRG(a1, b1, c1, 1)}; v[3] = (f32x4){MRG(a1, b1, c1, 2), MRG(a1, b1, c1, 3)}; \
            float ss = 0.f; \
            _Pragma("unroll") for (int j = 0; j < 4; ++j) ss += (v[j].x * v[j].x + v[j].y * v[j].y) + (v[j].z * v[j].z + v[j].w * v[j].w); \
            const float r = 1.0f / sqrtf(wave_sum(ss) * (1.0f / AW) + EPS); \
            _Pragma("unroll") for (int j = 0; j < 4; ++j) v[j] = v[j] * r * *(const f32x4*)(g + 16 * lane + 4 * j); \
            STOREV(it_); } while (0)
        int it = gw;
        if (it < 2 * MT) LOAD0(0, it);
        if (it + NGW < 2 * MT) LOAD0(1, it + NGW);
        for (; it < 2 * MT; it += 2 * NGW) {
            __builtin_amdgcn_sched_barrier(0);
            COMP0(0, it);
            if (it + 2 * NGW < 2 * MT) LOAD0(0, it + 2 * NGW);
            __builtin_amdgcn_sched_barrier(0);
            if (it + NGW < 2 * MT) { COMP0(1, it + NGW); if (it + 3 * NGW < 2 * MT) LOAD0(1, it + 3 * NGW); }
        }
#undef LOAD0
#undef COMP0
#undef MRG
    } else {
        v4u yq[2][2];
#define LOAD1(b, it_) do { const int m_ = (it_) >> 1; yq[b][0] = *(const v4u*)(YP + (size_t)m_ * 1024 + 16 * lane); yq[b][1] = *(const v4u*)(YP + (size_t)m_ * 1024 + 16 * lane + 8); } while (0)
#define COMP1(b, it_) do { f32x4 v[4]; const v4u a0 = yq[b][0], a1 = yq[b][1]; \
            v[0] = (f32x4){bflo(a0.x), bfhi(a0.x), bflo(a0.y), bfhi(a0.y)}; v[1] = (f32x4){bflo(a0.z), bfhi(a0.z), bflo(a0.w), bfhi(a0.w)}; \
            v[2] = (f32x4){bflo(a1.x), bfhi(a1.x), bflo(a1.y), bfhi(a1.y)}; v[3] = (f32x4){bflo(a1.z), bfhi(a1.z), bflo(a1.w), bfhi(a1.w)}; \
            float s = 0.f; \
            _Pragma("unroll") for (int j = 0; j < 4; ++j) s += (v[j].x + v[j].y) + (v[j].z + v[j].w); \
            const float mean = wave_sum(s) * (1.0f / CCH); float q = 0.f; \
            _Pragma("unroll") for (int j = 0; j < 4; ++j) { v[j] = v[j] - mean; q += (v[j].x * v[j].x + v[j].y * v[j].y) + (v[j].z * v[j].z + v[j].w * v[j].w); } \
            const float rstd = 1.0f / sqrtf(wave_sum(q) * (1.0f / CCH) + EPS); \
            _Pragma("unroll") for (int j = 0; j < 4; ++j) { f32x4 y = v[j] * rstd * *(const f32x4*)(lng + 16 * lane + 4 * j) + *(const f32x4*)(lnb + 16 * lane + 4 * j); \
                y.x *= sigm(y.x); y.y *= sigm(y.y); y.z *= sigm(y.z); y.w *= sigm(y.w); v[j] = y; } \
            STOREV(it_); } while (0)
        int it = gw;
        if (it < 2 * MT) LOAD1(0, it);
        if (it + NGW < 2 * MT) LOAD1(1, it + NGW);
        for (; it < 2 * MT; it += 2 * NGW) {
            __builtin_amdgcn_sched_barrier(0);
            COMP1(0, it);
            if (it + 2 * NGW < 2 * MT) LOAD1(0, it + 2 * NGW);
            __builtin_amdgcn_sched_barrier(0);
            if (it + NGW < 2 * MT) { COMP1(1, it + NGW); if (it + 3 * NGW < 2 * MT) LOAD1(1, it + 3 * NGW); }
        }
#undef LOAD1
#undef COMP1
    }
#undef STOREV
}
template <int K>
__device__ __forceinline__ void skinny_phase(Frame& F, const bf16* A, const bf16* Bt, int N, float* part) {
    LAS float* red = (LAS float*)(F.lds + RING_OFF);
    constexpr int Kq = K / 4, Kw = Kq / 8, NS = Kw / 16;
    const int lane = launder(F.lane), r = lane & 31, h = lane >> 5, nsl = N / 32; const int tid = launder(F.tid);
    for (int it = F.bid; it < nsl * 4; it += F.G) {
        const int ns = it >> 2, kq = it & 3, k0 = kq * Kq + F.wave * Kw;
        f32x16 acc0, acc1;
#pragma unroll
        for (int i = 0; i < 16; ++i) { acc0[i] = 0.f; acc1[i] = 0.f; }
        const bf16* a0p = A + (size_t)r * K + k0 + 8 * h; const bf16* a1p = a0p + (size_t)32 * K; const bf16* bp = Bt + (size_t)(ns * 32 + r) * K + k0 + 8 * h;
        bf16x8 a0[NS], a1[NS], bv[NS];
#pragma unroll
        for (int s = 0; s < NS; ++s) { a0[s] = *(const bf16x8*)(a0p + 16 * s); a1[s] = *(const bf16x8*)(a1p + 16 * s); bv[s] = *(const bf16x8*)(bp + 16 * s); }
        __builtin_amdgcn_sched_barrier(0);
#pragma unroll
        for (int s = 0; s < NS; ++s) { acc0 = __builtin_amdgcn_mfma_f32_32x32x16_bf16(a0[s], bv[s], acc0, 0, 0, 0); acc1 = __builtin_amdgcn_mfma_f32_32x32x16_bf16(a1[s], bv[s], acc1, 0, 0, 0); }
        __syncthreads();
#pragma unroll
        for (int i = 0; i < 16; ++i) { const int row = (i & 3) + 8 * (i >> 2) + 4 * h; red[(F.wave * 64 + row) * 32 + r] = acc0[i]; red[(F.wave * 64 + 32 + row) * 32 + r] = acc1[i]; }
        __syncthreads();
        { const int o = tid * 4, row = o >> 5, col = o & 31; f32x4 s = (f32x4){0.f, 0.f, 0.f, 0.f};
#pragma unroll
          for (int wv = 0; wv < 8; ++wv) s += *(const LAS f32x4*)(red + (wv * 64 + row) * 32 + col);
          *(f32x4*)(part + ((size_t)kq * MS + row) * N + ns * 32 + col) = s; }
    }
    __syncthreads();
}

namespace pg8 {
struct GatedOrder : StaticOrder {
    const unsigned* ready;
    __device__ __forceinline__ void a_ready(const Unit& u) const {
        if (u.pm == 32) {
            if (threadIdx.x < 64) { unsigned sp = 0;
                while ((unsigned)__builtin_amdgcn_readfirstlane(__hip_atomic_load(ready, __ATOMIC_RELAXED, __HIP_MEMORY_SCOPE_AGENT)) < 16u) { __builtin_amdgcn_s_sleep(2); if (++sp > (1u << 24)) break; }
                __builtin_amdgcn_fence(__ATOMIC_ACQUIRE, "agent");
                asm volatile("s_waitcnt vmcnt(0)" ::: "memory"); }
            asm volatile("" ::: "memory"); __builtin_amdgcn_s_barrier(); asm volatile("" ::: "memory");
        }
    }
};
__device__ __forceinline__ f32x4 ubl(const u32x4 v) { return (f32x4){__builtin_bit_cast(float, v.x << 16), __builtin_bit_cast(float, v.x & 0xffff0000u), __builtin_bit_cast(float, v.y << 16), __builtin_bit_cast(float, v.y & 0xffff0000u)}; }
__device__ __forceinline__ f32x4 ubh(const u32x4 v) { return (f32x4){__builtin_bit_cast(float, v.z << 16), __builtin_bit_cast(float, v.z & 0xffff0000u), __builtin_bit_cast(float, v.w << 16), __builtin_bit_cast(float, v.w & 0xffff0000u)}; }
__device__ __forceinline__ void row_stats_a(const f32x4 (&v)[2][2][4][2], const Unit& u, int wr, int wc, int fr, int fq, PG8_LAS unsigned char* lds, int wid, int lane, unsigned* xs, unsigned* cnt) {
    PG8_LAS float* P = (PG8_LAS float*)lds;
    PG8_LAS float* S = (PG8_LAS float*)(lds + 4096);
#pragma unroll
    for (int ai = 0; ai < 2; ++ai)
#pragma unroll
        for (int m = 0; m < 4; ++m) { float s = 0.f;
#pragma unroll
            for (int bj = 0; bj < 2; ++bj)
#pragma unroll
                for (int n = 0; n < 2; ++n) { const f32x4 x = v[ai][bj][m][n]; s += (x[0] * x[0] + x[1] * x[1]) + (x[2] * x[2] + x[3] * x[3]); }
            s += __shfl_xor(s, 16); s += __shfl_xor(s, 32);
            if (fq == 0) P[(ai * HALF + wr * 64 + m * 16 + fr) * 4 + wc] = s; }
    asm volatile("s_waitcnt lgkmcnt(0)" ::: "memory"); __builtin_amdgcn_s_barrier(); asm volatile("" ::: "memory");
    const int row = wid * 32 + (lane & 31);
    if (lane < 32) { const f32x4 p = *(const PG8_LAS f32x4*)(P + row * 4);
        __hip_atomic_store(xs + (size_t)(u.pm * BM + row) * 8 + u.pn, __builtin_bit_cast(unsigned, (p[0] + p[1]) + (p[2] + p[3])), __ATOMIC_RELAXED, __HIP_MEMORY_SCOPE_AGENT); }
    asm volatile("s_waitcnt vmcnt(0)" ::: "memory");
    if (lane == 0) __hip_atomic_fetch_add(cnt + 64 * u.pm, 1u, __ATOMIC_RELAXED, __HIP_MEMORY_SCOPE_AGENT);
    if (wid == 0) { unsigned sp = 0;
        while ((unsigned)__builtin_amdgcn_readfirstlane(__hip_atomic_load(cnt + 64 * u.pm, __ATOMIC_RELAXED, __HIP_MEMORY_SCOPE_AGENT)) < 64u) { __builtin_amdgcn_s_sleep(2); if (++sp > (1u << 24)) break; }
        __builtin_amdgcn_fence(__ATOMIC_ACQUIRE, "agent"); }
    asm volatile("s_waitcnt vmcnt(0) lgkmcnt(0)" ::: "memory"); __builtin_amdgcn_s_barrier(); asm volatile("" ::: "memory");
}
__device__ __forceinline__ void row_stats_b(const Unit& u, PG8_LAS unsigned char* lds, int wid, int lane, unsigned* xs) {
    PG8_LAS float* S = (PG8_LAS float*)(lds + 4096);
    const int row = wid * 32 + (lane & 31);
    if (lane < 32) { const unsigned* slot = xs + (size_t)(u.pm * BM + row) * 8; float q = 0.f;
#pragma unroll
        for (int t = 0; t < 8; ++t) q += __builtin_bit_cast(float, __hip_atomic_load(slot + t, __ATOMIC_RELAXED, __HIP_MEMORY_SCOPE_AGENT));
        S[row] = 1.0f / sqrtf(q * (1.0f / 2048.0f) + 1e-6f); }
    asm volatile("s_waitcnt lgkmcnt(0)" ::: "memory"); __builtin_amdgcn_s_barrier(); asm volatile("" ::: "memory");
}
struct EpiResNorm {
    static constexpr bool PERM = true, AFTER_DRAIN = true;
    unsigned char* ws; float* out32;
    unsigned og, oa, ob, ocnt;
    __device__ __forceinline__ void fused(f32x4 (&acc)[2][2][4][2], const Unit& u, int wr, int wc, int fr, int fq, PG8_LAS unsigned char* lds, int wid, int lane) const {
        const PG8_LAS float* S = (const PG8_LAS float*)(lds + 4096);
        bf16_t* XR = (bf16_t*)(ws + WS_XRES); const bf16_t* MODT = (const bf16_t*)(ws + WS_MOD);
        unsigned* xs = (unsigned*)(ws + WS_O32); unsigned* cnt = (unsigned*)(ws + WS_CTL) + ocnt;
        const int c0 = u.pn * BM + wc * 32 + 8 * fq; const size_t vo = (size_t)(u.pm >> 3) * NMOD + c0;
        u32x4 g1[2];
#pragma unroll
        for (int bj = 0; bj < 2; ++bj) g1[bj] = *(const u32x4*)(MODT + og + vo + bj * HALF);
        u32x4 pre[4][2];
#pragma unroll
        for (int m = 0; m < 4; ++m)
#pragma unroll
            for (int bj = 0; bj < 2; ++bj) pre[m][bj] = *(const u32x4*)(XR + (size_t)(u.pm * BM + wr * 64 + m * 16 + fr) * D + c0 + bj * HALF);
        row_stats_a(acc, u, wr, wc, fr, fq, lds, wid, lane, xs, cnt);
        u32x4 pre1[4][2];
#pragma unroll
        for (int m = 0; m < 4; ++m)
#pragma unroll
            for (int bj = 0; bj < 2; ++bj) pre1[m][bj] = *(const u32x4*)(XR + (size_t)(u.pm * BM + HALF + wr * 64 + m * 16 + fr) * D + c0 + bj * HALF);
        row_stats_b(u, lds, wid, lane, xs);
#pragma unroll
        for (int ai = 0; ai < 2; ++ai)
#pragma unroll
            for (int m = 0; m < 4; ++m) { const int r = ai * HALF + wr * 64 + m * 16 + fr; const float rs = S[r];
#pragma unroll
                for (int bj = 0; bj < 2; ++bj) { const u32x4 xq = ai == 0 ? pre[m][bj] : pre1[m][bj];
                    acc[ai][bj][m][0] = ubl(xq) + ubl(g1[bj]) * (acc[ai][bj][m][0] * rs); acc[ai][bj][m][1] = ubh(xq) + ubh(g1[bj]) * (acc[ai][bj][m][1] * rs); }
                asm volatile("" : "+v"(acc[ai][0][m][0]), "+v"(acc[ai][0][m][1]), "+v"(acc[ai][1][m][0]), "+v"(acc[ai][1][m][1])); }
        if (out32) {
#pragma unroll
            for (int ai = 0; ai < 2; ++ai)
#pragma unroll
                for (int m = 0; m < 4; ++m) { float* o = out32 + (size_t)(u.pm * BM + ai * HALF + wr * 64 + m * 16 + fr) * D + c0;
#pragma unroll
                    for (int bj = 0; bj < 2; ++bj) { *(f32x4*)(o + bj * HALF) = acc[ai][bj][m][0]; *(f32x4*)(o + bj * HALF + 4) = acc[ai][bj][m][1]; } }
        } else {
            bf16_t* Hh = (bf16_t*)(ws + WS_H);
            u32x4 g2[2], g3[2];
#pragma unroll
            for (int bj = 0; bj < 2; ++bj) { g2[bj] = *(const u32x4*)(MODT + oa + vo + bj * HALF); g3[bj] = *(const u32x4*)(MODT + ob + vo + bj * HALF); }
            row_stats_a(acc, u, wr, wc, fr, fq, lds, wid, lane, xs + 8192 * 8, cnt + 2048); row_stats_b(u, lds, wid, lane, xs + 8192 * 8);
#pragma unroll
            for (int ai = 0; ai < 2; ++ai)
#pragma unroll
                for (int m = 0; m < 4; ++m) { const int r = ai * HALF + wr * 64 + m * 16 + fr; const float rs = S[r]; const size_t off = (size_t)(u.pm * BM + r) * D + c0;
#pragma unroll
                    for (int bj = 0; bj < 2; ++bj) { const f32x4 x0 = acc[ai][bj][m][0], x1 = acc[ai][bj][m][1];
                        *(u32x4*)(XR + off + bj * HALF) = pack8(x0, x1);
                        *(u32x4*)(Hh + off + bj * HALF) = pack8(x0 * rs * ubl(g2[bj]) + ubl(g3[bj]), x1 * rs * ubh(g2[bj]) + ubh(g3[bj])); } }
        }
    }
};
}

#ifndef N_LAUNCH_MODE
#define N_LAUNCH_MODE 1
#endif
struct Args { const float* in[N_IN]; float* out; unsigned char* ws; int ph_lo, ph_hi; };
constexpr int PH_PRO = 3, PH_PER_LAYER = 8, PH_TOTAL = PH_PRO + DEPTH * PH_PER_LAYER;
__global__ void __launch_bounds__(NWAVES * 64, 2) fwd(Args args) {
    extern __shared__ __attribute__((aligned(16))) unsigned char lds[];
    Frame F;
    F.lds = (LAS unsigned char*)lds;
    F.MISC = (volatile LAS unsigned*)(F.lds + MISC_OFF);
    F.tid = threadIdx.x; F.lane = F.tid & 63; F.wave = __builtin_amdgcn_readfirstlane(F.tid >> 6);
    F.G = gridDim.x; F.bid = blockIdx.x;
    F.ws = args.ws; F.out = args.out; F.ctl = (gu32*)(args.ws + WS_CTL);
    for (int u = F.tid; u < (LDS_BYTES - LDSCTL_OFF) / 4; u += NWAVES * 64) ((LAS unsigned*)(F.lds + LDSCTL_OFF))[u] = 0u;
    __syncthreads();
    if (F.tid == 0) {
#pragma unroll
        for (int i = 0; i < N_IN; ++i) ((LAS unsigned long long*)(F.lds + LDSCTL_OFF))[i] = (unsigned long long)args.in[i];
    }
    __syncthreads();
#if N_LAUNCH_MODE == 1
    constexpr int lo = 0, hi = PH_TOTAL; constexpr bool multi = true;
#else
    const int lo = args.ph_lo, hi = args.ph_hi;
    const bool multi = (hi - lo) > 1;
#endif
    XcdBarrier bar; bar.bar = (unsigned*)(F.ctl + CW_BAR); bar.x = 0; bar.st = nullptr;
    if (multi) bar = xcd_barrier_post((unsigned*)(F.ctl + CW_BAR), F.MISC + 8);
#define RELAUNDER() do { F.lane = lane_id_now(); F.tid = F.wave * 64 + F.lane; { unsigned long long w_ = (unsigned long long)F.ws, o_ = (unsigned long long)F.out; asm volatile("" : "+s"(w_), "+s"(o_)); F.ws = (unsigned char*)(GAS unsigned char*)w_; F.out = (float*)(GAS float*)o_; } } while (0)
#define RELAUNDER_V() (F.wave * 64 + lane_id_now())
#define IN(k) (lo <= (k) && (k) < hi)
#define SEAM(k) do { if (IN(k) && IN((k) + 1)) { xcd_barrier(bar); if (PROBE_DUP == 200) xcd_barrier(bar); } } while (0)

#define Hb ((bf16*)(F.ws + WS_H))
#define SIGW(k) ((unsigned*)(F.ws + WS_CTL) + 131072 + 64 * (k))
#define MIXIN ((bf16*)(F.ws + WS_MIXIN))
#define MIX ((bf16*)(F.ws + WS_MIX))
#define FACT ((bf16*)(F.ws + WS_FACT))
#define Fb ((bf16*)(F.ws + WS_F))
#define SKP ((float*)(F.ws + WS_SKP))
#define MOD ((const bf16*)(F.ws + WS_MOD))

#ifndef PHMASK
#define PHMASK 0xFFFF
#endif
#define PM(k) ((PHMASK >> (k)) & 1)
#ifndef PROBE_DUP
#define PROBE_DUP (-1)
#endif
#define REP(k) for (int rep_ = 0; rep_ < ((PROBE_DUP == (k)) ? 2 : 1); ++rep_)
    if (PM(0) && IN(0)) { REP(0) { REP(100) { RELAUNDER(); p0_transposes(F); } REP(101) { RELAUNDER(); p0_mod_partials(F); } REP(102) { RELAUNDER(); if (F.G != 256) p0_cache_copy(F); } } } SEAM(0);
    if (PM(1) && IN(1)) { RELAUNDER(); p0_mod_reduce(F); } SEAM(1);
    if (PM(2) && IN(2)) {
        RELAUNDER();
        resnorm_rows<false, true>(F, INP(I_XP), INP(I_XS), nullptr, nullptr, nullptr, nullptr, nullptr, MOD + 1 * D, MOD + 0 * D, Hb, SIGW(8));
    } SEAM(2);

    for (int l = 0; l < DEPTH; ++l) {
        const int pb = PH_PRO + l * PH_PER_LAYER;
#define modl (MOD + (size_t)l * 12 * NMOD)
        if (PM(3) && IN(pb + 0)) REP(3) {
            pg8::Gemm g{Hb, (const bf16*)(F.ws + WS_WIN + l * SZ_WIN), MPAD, NIN, D}; pg8::GatedOrder S; S.init(MPAD, NIN, F.G, F.bid); S.ready = SIGW(l == 0 ? 8 : (l - 1) * 2 + 1);
            pg8::EpiIn E{(bf16*)(F.ws + WS_Q), (size_t)(WS_K - WS_Q) / 2, (bf16*)(F.ws + WS_U),
                         F.out + O_KP + (size_t)l * MP * 1024, (size_t)(O_VP - O_KP), F.out + O_KS + (size_t)l * 8 * WBUF * 1024, (size_t)(O_VS - O_KS), QSCALE};
            pg8::gemm_phase<pg8::EpiIn, pg8::GatedOrder, true, true>(F.lds + RING_OFF, g, S, E, (RELAUNDER_V()));
            if (F.G == 256 && F.bid >= 148) { RELAUNDER(); tail_copy(F, l, F.bid - 148); }
        } SEAM(pb + 0);
        if (PM(4) && IN(pb + 1)) REP(4) {
#ifndef NO_ATTN
            RELAUNDER();
            REP(40) { RELAUNDER(); attn_mfma_phase(F); }
            RELAUNDER();
            REP(41) attn_sample_phase(F, l);
#endif
#ifndef NO_CONV
            RELAUNDER();
            REP(42) conv_phase(F, l);
#endif
        } SEAM(pb + 1);
        if (PM(5) && IN(pb + 2)) REP(5) { RELAUNDER(); onorm_phase(F, l); } SEAM(pb + 2);
        if (PM(6) && IN(pb + 3)) REP(6) {
            pg8::Gemm g{MIXIN, (const bf16*)(F.ws + WS_WOUT + l * SZ_WOUT), MP, D, D}; pg8::StaticOrder S; S.init(MP, D, F.G, F.bid);
            pg8::EpiResNorm E{F.ws, nullptr, (unsigned)(l * 12 * NMOD + 2 * D), (unsigned)(l * 12 * NMOD + 4 * D), (unsigned)(l * 12 * NMOD + 3 * D), (unsigned)(65536 + (l * 2 + 0) * 4096)};
            pg8::gemm_phase<pg8::EpiResNorm, pg8::StaticOrder, true, true>(F.lds + RING_OFF, g, S, E, (RELAUNDER_V()));
#ifndef NO_SKINNY
            RELAUNDER();
            skinny_phase<D>(F, MIXIN + (size_t)MP * D, (const bf16*)(F.ws + WS_WOUT + l * SZ_WOUT), D, SKP);
#endif
        } SEAM(pb + 3);
        if (PM(7) && IN(pb + 4)) {
            RELAUNDER();
            resnorm_rows<true, false, false>(F, nullptr, nullptr, nullptr, nullptr, MIX, SKP, modl + 2 * D, modl + 4 * D, modl + 3 * D, Hb, SIGW(l * 2 + 0));
        }
        if (PM(8) && IN(pb + 5)) REP(8) {
            pg8::Gemm g{Hb, (const bf16*)(F.ws + WS_WGU + l * SZ_WGU), MPAD, NGU, D}; pg8::GatedOrder S; S.init(MPAD, NGU, F.G, F.bid); S.ready = SIGW(l * 2 + 0);
            pg8::EpiSwiGLU E{FACT, DFF};
            pg8::gemm_phase<pg8::EpiSwiGLU, pg8::GatedOrder, true, true>(F.lds + RING_OFF, g, S, E, (RELAUNDER_V()));
            if (F.G == 256 && F.bid >= 172) { RELAUNDER(); tail_copy(F, l, 108 + F.bid - 172); }
        } SEAM(pb + 5);
        if (PM(9) && IN(pb + 6)) REP(9) {
            pg8::Gemm g{FACT, (const bf16*)(F.ws + WS_WDN + l * SZ_WDN), MP, D, DFF}; pg8::StaticOrder S; S.init(MP, D, F.G, F.bid);
            const int ln = (l == DEPTH - 1) ? l : l + 1;
            pg8::EpiResNorm E{F.ws, (l == DEPTH - 1) ? F.out + O_YP : nullptr, (unsigned)(l * 12 * NMOD + 5 * D), (unsigned)(ln * 12 * NMOD + 1 * D), (unsigned)(ln * 12 * NMOD + 0 * D), (unsigned)(65536 + (l * 2 + 1) * 4096)};
            pg8::gemm_phase<pg8::EpiResNorm, pg8::StaticOrder, true, true>(F.lds + RING_OFF, g, S, E, (RELAUNDER_V()));
#ifndef NO_SKINNY
            RELAUNDER();
            skinny_phase<DFF>(F, FACT + (size_t)MP * DFF, (const bf16*)(F.ws + WS_WDN + l * SZ_WDN), D, SKP);
#endif
        } SEAM(pb + 6);
        if (PM(10) && IN(pb + 7)) {
            const bool last = (l == DEPTH - 1);
            float* op = last ? F.out + O_YP : nullptr; float* os = last ? F.out + O_YS : nullptr;
            const bf16* modn = MOD + (size_t)(last ? l : l + 1) * 12 * NMOD;
            RELAUNDER();
            resnorm_rows<true, false, false>(F, nullptr, nullptr, op, os, Fb, SKP, modl + 5 * D, modn + 1 * D, modn + 0 * D, last ? nullptr : Hb, SIGW(l * 2 + 1));
        }
    }
#undef IN
#undef SEAM
#undef Hb
#undef MIXIN
#undef MIX
#undef FACT
#undef Fb
#undef SKP
#undef MOD
#undef modl
}

extern "C" void kernel_launch(void* const* d_in, const int* in_sizes, int n_in, void* d_out, int out_size, void* d_ws, size_t ws_size, hipStream_t stream) {
    static int grid = 0;
    if (grid == 0) {
        if (n_in != N_IN || (size_t)out_size != O_END || ws_size < WS_END) { fprintf(stderr, "kernel_launch: unexpected shapes: n_in %d out %d ws %zu (need %zu)\n", n_in, out_size, ws_size, (size_t)WS_END); grid = -1; return; }
        int dev = 0, cus = 0, per_cu = 0;
        if (hipGetDevice(&dev) != hipSuccess || hipDeviceGetAttribute(&cus, hipDeviceAttributeMultiprocessorCount, dev) != hipSuccess) { grid = -1; return; }
        if (hipFuncSetAttribute((const void*)fwd, hipFuncAttributeMaxDynamicSharedMemorySize, LDS_BYTES) != hipSuccess) { fprintf(stderr, "kernel_launch: hipFuncSetAttribute failed\n"); grid = -1; return; }
        if (hipOccupancyMaxActiveBlocksPerMultiprocessor(&per_cu, (const void*)fwd, NWAVES * 64, LDS_BYTES) != hipSuccess || per_cu < 1) fprintf(stderr, "kernel_launch: occupancy query says %d\n", per_cu);
        (void)hipGetLastError();
        if (cus != 256) { fprintf(stderr, "kernel_launch: built for 256 CUs (one 256x256 unit per workgroup in the fused-norm GEMM phases), device has %d\n", cus); grid = -1; return; }
        grid = cus;
    }
    if (grid < 0) return;
    if (hipMemsetAsync((char*)d_ws + WS_CTL, 0, CTL_ZERO_BYTES, stream) != hipSuccess) return;
    Args a{};
    for (int i = 0; i < N_IN; ++i) a.in[i] = (const float*)d_in[i];
    a.out = (float*)d_out; a.ws = (unsigned char*)d_ws;
    if (N_LAUNCH_MODE == 1) { a.ph_lo = 0; a.ph_hi = PH_TOTAL; hipLaunchKernelGGL(fwd, dim3(grid), dim3(NWAVES * 64), LDS_BYTES, stream, a); }
    else for (int p = 0; p < PH_TOTAL; ++p) { a.ph_lo = p; a.ph_hi = p + 1; hipLaunchKernelGGL(fwd, dim3(grid), dim3(NWAVES * 64), LDS_BYTES, stream, a); }
}
```
